# Optimizing an MI355X kernel written in HIP

```python
import math
import jax, jax.numpy as jnp
from jax import lax
import numpy as np

D_MODEL = 1024
BATCH = 8
SEQ = 2048
DEPTH = 2

N_HEADS = 16
HEAD_DIM = D_MODEL // N_HEADS
ATTN_W = N_HEADS * HEAD_DIM
DIL_PAIRS = ((128, 1), (512, 4), (2048, 16))
N_DIL = len(DIL_PAIRS)
BLOCK = 128
KV_RANK = 256
N_IDX_HEADS = 8
IDX_DIM = 64
TOPK_MAX = 256
N_MEM = 256
N_CROSS_HEADS = 4
CROSS_HEAD_DIM = 64
CROSS_WIDTH = N_CROSS_HEADS * CROSS_HEAD_DIM
REL_BUCKETS = 32
REL_MAX_DIST = 2048
D_FF_DENSE = 2816
N_EXPERTS = 8
TOP_K_EXPERTS = 2
D_FF_EXPERT = 3584
RMS_EPS = 1e-6
NEG_INF = -1e30
A_IN = N_DIL * ATTN_W + 2 * ATTN_W + CROSS_WIDTH
B_IN = ATTN_W + KV_RANK + N_IDX_HEADS * IDX_DIM + IDX_DIM + N_IDX_HEADS + CROSS_WIDTH
OUT_IN = ATTN_W + CROSS_WIDTH
N_EVEN = (DEPTH + 1) // 2
N_ODD = DEPTH // 2

kernel_name = "hybrid_dilated_dsa_moe_decoder"


def rmsnorm(x, g):
    xf = x.astype(jnp.float32)
    y = xf * lax.rsqrt(jnp.mean(xf * xf, axis=-1, keepdims=True) + RMS_EPS)
    return (y * g.astype(jnp.float32)).astype(x.dtype)


def split_cols(t, sizes):
    offs = np.cumsum(np.array(sizes))[:-1].tolist()
    return jnp.split(t, offs, axis=-1)


def rel_bucket(dist):
    n = jnp.maximum(dist, 0)
    max_exact = REL_BUCKETS // 2
    nf = jnp.maximum(n, 1).astype(jnp.float32)
    large = max_exact + (jnp.log(nf / max_exact) / math.log(REL_MAX_DIST / max_exact)
                         * (REL_BUCKETS - max_exact)).astype(jnp.int32)
    large = jnp.minimum(large, REL_BUCKETS - 1)
    return jnp.where(n < max_exact, n, large)


def dilated_branch(q, k, v, rel_bias, window, dilation):
    B, S, H, hd = q.shape
    L = S // dilation
    Lp = -(-L // BLOCK) * BLOCK
    nb = Lp // BLOCK
    span = window // dilation

    def to_sub(t):
        t = t.reshape(B, L, dilation, H, hd).transpose(0, 2, 1, 3, 4)
        t = jnp.pad(t, ((0, 0), (0, 0), (0, Lp - L), (0, 0), (0, 0)))
        return t.reshape(B, dilation, nb, BLOCK, H, hd)

    def with_prev(t):
        prev = jnp.pad(t, ((0, 0), (0, 0), (1, 0), (0, 0), (0, 0), (0, 0)))[:, :, :-1]
        return jnp.concatenate([prev, t], axis=3)

    qs = to_sub(q)
    kk = with_prev(to_sub(k))
    vv = with_prev(to_sub(v))
    scores = jnp.einsum('bdnqhc,bdnkhc->bdnhqk', qs, kk,
                        preferred_element_type=jnp.float32) * (hd ** -0.5)
    qi = jnp.arange(BLOCK)[:, None]
    ki = jnp.arange(2 * BLOCK)[None, :]
    rel = qi + BLOCK - ki
    bias = jnp.moveaxis(rel_bias[rel_bucket(rel * dilation)], -1, 0).astype(jnp.float32)
    kpos = jnp.arange(nb)[:, None, None] * BLOCK + ki[None] - BLOCK
    allowed = (rel[None] >= 0) & (rel[None] <= span) & (kpos >= 0)
    scores = jnp.where(allowed[:, None], scores + bias, NEG_INF)
    m = jnp.max(scores, axis=-1)
    p = jnp.exp(scores - m[..., None])
    l = jnp.sum(p, axis=-1)
    o = jnp.einsum('bdnhqk,bdnkhc->bdnqhc', p, vv.astype(jnp.float32))

    def from_sub(t):
        t = t.reshape((B, dilation, Lp) + t.shape[4:])[:, :, :L]
        return jnp.swapaxes(t, 1, 2).reshape((B, S) + t.shape[3:])

    return (from_sub(o), from_sub(jnp.swapaxes(m, -1, -2)), from_sub(jnp.swapaxes(l, -1, -2)))


def mixer_dilated(q_groups, k, v, rel_bias):
    B, S, _ = k.shape
    heads = lambda t: t.reshape(B, S, N_HEADS, HEAD_DIM)
    kh, vh = heads(k), heads(v)
    branches = [dilated_branch(heads(qg), kh, vh, rel_bias, w, d)
                for qg, (w, d) in zip(q_groups, DIL_PAIRS)]
    m_max = jnp.max(jnp.stack([b[1] for b in branches]), axis=0)
    num = jnp.zeros_like(branches[0][0])
    den = jnp.zeros_like(m_max)
    for o_g, m_g, l_g in branches:
        a = jnp.exp(m_g - m_max)
        num = num + a[..., None] * o_g
        den = den + a * l_g
    return (num / den[..., None]).astype(k.dtype).reshape(B, S, ATTN_W)


def mixer_dsa(q, c_kv, q_idx, k_idx, w_idx, w_uk, w_uv, rel_bias):
    B, S, _ = q.shape
    topk = min(TOPK_MAX, S // 4)
    nb = S // BLOCK
    qh = q.reshape(B, S, N_HEADS, HEAD_DIM)
    q_lat = jnp.einsum('bshc,rhc->bshr', qh, w_uk)
    q_idx = q_idx.reshape(B, S, N_IDX_HEADS, IDX_DIM)
    k_idx_f = k_idx.astype(jnp.float32)

    def blockify(t):
        return jnp.moveaxis(t.reshape((B, nb, BLOCK) + t.shape[2:]), 1, 0)

    def one_block(args):
        i, ql, qib, wib = args
        s = jnp.einsum('bqhc,bsc->bqhs', qib.astype(jnp.float32), k_idx_f) * (IDX_DIM ** -0.5)
        score = jnp.einsum('bqh,bqhs->bqs', wib.astype(jnp.float32) * (N_IDX_HEADS ** -0.5),
                           jax.nn.relu(s))
        tpos = i * BLOCK + jnp.arange(BLOCK)
        causal = jnp.arange(S)[None, :] <= tpos[:, None]
        score = jnp.where(causal[None], score, NEG_INF)
        _, idx = lax.top_k(score, topk)
        valid = idx <= tpos[None, :, None]
        c_sel = jax.vmap(lambda c, ix: c[ix])(c_kv, idx)
        logits = jnp.einsum('bqhr,bqkr->bhqk', ql, c_sel,
                            preferred_element_type=jnp.float32) * (HEAD_DIM ** -0.5)
        bias = rel_bias[rel_bucket(tpos[None, :, None] - idx)]
        logits = logits + jnp.moveaxis(bias, -1, 1).astype(jnp.float32)
        logits = jnp.where(valid[:, None], logits, NEG_INF)
        p = jax.nn.softmax(logits, axis=-1)
        o_lat = jnp.einsum('bhqk,bqkr->bqhr', p, c_sel.astype(jnp.float32))
        return o_lat.astype(q.dtype)

    o_lat = lax.map(one_block, (jnp.arange(nb), blockify(q_lat), blockify(q_idx), blockify(w_idx)))
    o_lat = jnp.moveaxis(o_lat, 0, 1).reshape(B, S, N_HEADS, KV_RANK)
    o = jnp.einsum('bshr,rhc->bshc', o_lat, w_uv)
    return o.reshape(B, S, ATTN_W)


def cross_attention(qc, mem_n, w_mem_kv):
    B, S, _ = qc.shape
    kv = jnp.einsum('bnd,de->bne', mem_n, w_mem_kv)
    k, v = jnp.split(kv, 2, axis=-1)
    k = k.reshape(B, N_MEM, N_CROSS_HEADS, CROSS_HEAD_DIM)
    v = v.reshape(B, N_MEM, N_CROSS_HEADS, CROSS_HEAD_DIM)
    q = qc.reshape(B, S, N_CROSS_HEADS, CROSS_HEAD_DIM)
    logits = jnp.einsum('bshc,bnhc->bhsn', q, k,
                        preferred_element_type=jnp.float32) * (CROSS_HEAD_DIM ** -0.5)
    p = jax.nn.softmax(logits, axis=-1)
    o = jnp.einsum('bhsn,bnhc->bshc', p, v.astype(jnp.float32))
    return o.astype(qc.dtype).reshape(B, S, CROSS_WIDTH)


def swiglu(h, w_gate, w_up, w_down):
    return (jax.nn.silu(h @ w_gate) * (h @ w_up)) @ w_down


def moe_swiglu(h, w_router, w_gate, w_up, w_down):
    B, S, D = h.shape
    t = h.reshape(B * S, D)
    logits = (t @ w_router).astype(jnp.float32)
    top_val, top_idx = lax.top_k(logits, TOP_K_EXPERTS)
    gate_top = jax.nn.softmax(top_val, axis=-1)
    gates = jnp.sum(jax.nn.one_hot(top_idx, N_EXPERTS, dtype=jnp.float32) * gate_top[..., None], axis=1)
    y = jnp.zeros((B * S, D), jnp.float32)
    for e in range(N_EXPERTS):
        y = y + gates[:, e:e + 1] * swiglu(t, w_gate[e], w_up[e], w_down[e]).astype(jnp.float32)
    return y.astype(h.dtype).reshape(B, S, D)


def setup_inputs(seed: int = 0) -> dict:
    key = jax.random.key(seed)
    ks = iter(jax.random.split(key, 32))
    nrm = lambda shape, fan_in: jax.random.normal(next(ks), shape, jnp.float32) * (fan_in ** -0.5)
    gain = lambda shape: 1.0 + 0.02 * jax.random.normal(next(ks), shape, jnp.float32)
    D = D_MODEL
    return {
        "x": jax.random.normal(next(ks), (BATCH, SEQ, D), jnp.float32),
        "mem": jax.random.normal(next(ks), (BATCH, N_MEM, D), jnp.float32),
        "rel_bias": 0.2 * jax.random.normal(next(ks), (REL_BUCKETS, N_HEADS), jnp.float32),
        "mem_norm": gain((D,)),
        "final_norm": gain((D,)),
        "mixer_norm": gain((DEPTH, D)),
        "ffn_norm": gain((DEPTH, D)),
        "w_mem_kv": nrm((DEPTH, D, 2 * CROSS_WIDTH), D),
        "w_out": nrm((DEPTH, OUT_IN, D), OUT_IN),
        "even_w_in": nrm((N_EVEN, D, A_IN), D),
        "even_w_gate": nrm((N_EVEN, D, D_FF_DENSE), D),
        "even_w_up": nrm((N_EVEN, D, D_FF_DENSE), D),
        "even_w_down": nrm((N_EVEN, D_FF_DENSE, D), D_FF_DENSE),
        "odd_w_in": nrm((N_ODD, D, B_IN), D),
        "odd_kv_norm": gain((N_ODD, KV_RANK)),
        "odd_w_uk": nrm((N_ODD, KV_RANK, N_HEADS, HEAD_DIM), KV_RANK),
        "odd_w_uv": nrm((N_ODD, KV_RANK, N_HEADS, HEAD_DIM), KV_RANK),
        "odd_w_router": nrm((N_ODD, D, N_EXPERTS), D),
        "odd_w_gate": nrm((N_ODD, N_EXPERTS, D, D_FF_EXPERT), D),
        "odd_w_up": nrm((N_ODD, N_EXPERTS, D, D_FF_EXPERT), D),
        "odd_w_down": nrm((N_ODD, N_EXPERTS, D_FF_EXPERT, D), D_FF_EXPERT),
    }


def reference(x, mem, rel_bias, mem_norm, final_norm, mixer_norm, ffn_norm, w_mem_kv, w_out,
              even_w_in, even_w_gate, even_w_up, even_w_down,
              odd_w_in, odd_kv_norm, odd_w_uk, odd_w_uv,
              odd_w_router, odd_w_gate, odd_w_up, odd_w_down):
    mem_n = rmsnorm(mem, mem_norm)
    for i in range(DEPTH):
        j = i // 2
        h = rmsnorm(x, mixer_norm[i])
        if i % 2 == 0:
            parts = split_cols(h @ even_w_in[j], [ATTN_W] * N_DIL + [ATTN_W, ATTN_W, CROSS_WIDTH])
            mix = mixer_dilated(parts[:N_DIL], parts[N_DIL], parts[N_DIL + 1], rel_bias)
            qc = parts[N_DIL + 2]
        else:
            q, c_kv, q_idx, k_idx, w_idx, qc = split_cols(
                h @ odd_w_in[j],
                [ATTN_W, KV_RANK, N_IDX_HEADS * IDX_DIM, IDX_DIM, N_IDX_HEADS, CROSS_WIDTH])
            c_kv = rmsnorm(c_kv, odd_kv_norm[j])
            mix = mixer_dsa(q, c_kv, q_idx, k_idx, w_idx, odd_w_uk[j], odd_w_uv[j], rel_bias)
        cross = cross_attention(qc, mem_n, w_mem_kv[i])
        x = x + jnp.concatenate([mix, cross], axis=-1) @ w_out[i]
        h = rmsnorm(x, ffn_norm[i])
        if i % 2 == 0:
            x = x + swiglu(h, even_w_gate[j], even_w_up[j], even_w_down[j])
        else:
            x = x + moe_swiglu(h, odd_w_router[j], odd_w_gate[j], odd_w_up[j], odd_w_down[j])
    return rmsnorm(x, final_norm)
```

```cpp
#include <hip/hip_runtime.h>
#include <stdint.h>
#include <stdio.h>

typedef unsigned short bf16_t;
#define DI __device__ __forceinline__

namespace cfg {
constexpr int B = 8, S = 2048, T = B * S, D = 1024;
constexpr int A_IN = 5376, B_INP = 2304;
constexpr int FF0 = 2816, FF1 = 3584, NE = 8;
constexpr int NMEM = 256;
constexpr int OUT_IN = 1280;
constexpr int NTHR = 512, NWAVE = 8;
constexpr int LDS_BYTES = 149504;
constexpr int P1_Q = 0, P1_CKV = 1024, P1_QIDX = 1280, P1_QC = 1792, P1_KIDX = 2048, P1_WIDX = 2112;
constexpr int P0_K = 3072, P0_V = 4096, P0_QC = 5120;
constexpr size_t RB_PROJ0 = 0, RB_MIXCAT = (size_t)T * A_IN * 2;
constexpr size_t RB_ACT0 = 0;
constexpr size_t RB_PROJ1 = 0, RB_KVFULL = (size_t)T * B_INP * 2, RB_CKV = RB_KVFULL + (size_t)T * 2048 * 2,
                 RB_BITMASK = RB_CKV + (size_t)T * 256 * 2, RB_IDX = RB_BITMASK + (size_t)T * 64 * 4, RB_L1END = RB_IDX + (size_t)T * 256 * 2;
constexpr size_t RB_MIN = RB_MIXCAT + (size_t)T * OUT_IN * 2;
static_assert(RB_L1END <= RB_MIXCAT, "layer-1 scratch overlaps mixcat");
}
using namespace cfg;

struct P {
    const float *x, *mem, *rel_bias, *mem_norm, *final_norm, *mixer_norm, *ffn_norm, *w_mem_kv, *w_out;
    const float *e_w_in, *e_w_gate, *e_w_up, *e_w_down;
    const float *o_w_in, *o_kv_norm, *o_w_uk, *o_w_uv, *o_w_router, *o_w_gate, *o_w_up, *o_w_down;
    float* out;
    unsigned* ctl;
    float* biasd;
    bf16_t *Wt_in0, *Wt_gu0, *Wt_down0, *Wt_out, *Wt_in1, *Wt_memkv, *Wt_ukv, *Wt_gu1, *Wt_down1;
    bf16_t *memn, *kvmem, *h;
    int *tok_e, *tok_pos; float* tok_g; int* lists;
    char* rb;
    int nsplit, ph_lo, ph_hi, pad;
};

constexpr int CTL_CNT = 4096;
constexpr int CTL_WORDS = 8192;

DI float bf2f(bf16_t b) { return __uint_as_float(((unsigned)b) << 16); }
DI bf16_t f2bf(float f) { unsigned u = __float_as_uint(f); u += 0x7FFFu + ((u >> 16) & 1u); return (bf16_t)(u >> 16); }
DI float wave_sum(float v) { for (int o = 32; o >= 1; o >>= 1) v += __shfl_xor(v, o); return v; }
DI float wave_max(float v) { for (int o = 32; o >= 1; o >>= 1) v = fmaxf(v, __shfl_xor(v, o)); return v; }
DI void wave_lds_sync() { asm volatile("s_waitcnt lgkmcnt(0)" ::: "memory"); __builtin_amdgcn_wave_barrier(); asm volatile("" ::: "memory"); }

DI int colmap(int mode, int n, int& which) {
    which = 0;
    if (mode == 0) return n;
    if (mode == 1) { const int j = n >> 8, r = n & 255; which = (r >= 128); return j * 128 + (r & 127); }
    if (n < 1792) return n;
    if (n < 2048) return 1864 + (n - 1792);
    if (n < 2112) return 1792 + (n - 2048);
    if (n < 2120) return 1856 + (n - 2112);
    return -1;
}
DI void conv_job(const float* s0, const float* s1, int ld, int K, int Nd, bf16_t* dst, int mode, float* sm) {
    const int tid = threadIdx.x, nk = K / 64, nn = Nd / 64, nt = nk * nn;
    for (int t = blockIdx.x; t < nt; t += gridDim.x) {
        const int tk = t % nk, tn = t / nk, k0 = tk * 64, n0 = tn * 64;
        {
            const int nl = tid & 63; int which; const int c = colmap(mode, n0 + nl, which);
            const float* s = which ? s1 : s0;
#pragma unroll
            for (int i = 0; i < 8; ++i) { const int kl = (tid >> 6) + 8 * i; sm[kl * 65 + nl] = (c >= 0) ? s[(size_t)(k0 + kl) * ld + c] : 0.f; }
        }
        __syncthreads();
        {
            const int kl = tid & 63;
#pragma unroll
            for (int i = 0; i < 8; ++i) { const int nl = (tid >> 6) + 8 * i; dst[(size_t)(n0 + nl) * K + k0 + kl] = f2bf(sm[kl * 65 + nl]); }
        }
        __syncthreads();
    }
}

DI void rms_rows_bf16(const float* src, int rows, const float* g, bf16_t* dst) {
    const int lane = threadIdx.x & 63, gw = blockIdx.x * NWAVE + (threadIdx.x >> 6), nw = gridDim.x * NWAVE;
    for (int r = gw; r < rows; r += nw) {
        const float4* s = (const float4*)(src + (size_t)r * D);
        float4 v[4]; float ss = 0.f;
#pragma unroll
        for (int i = 0; i < 4; ++i) { v[i] = s[lane + 64 * i]; ss += v[i].x * v[i].x + v[i].y * v[i].y + v[i].z * v[i].z + v[i].w * v[i].w; }
        ss = wave_sum(ss);
        const float rstd = rsqrtf(ss * (1.0f / D) + 1e-6f);
#pragma unroll
        for (int i = 0; i < 4; ++i) {
            const float4 gg = ((const float4*)g)[lane + 64 * i];
            ushort4 o; o.x = f2bf(v[i].x * rstd * gg.x); o.y = f2bf(v[i].y * rstd * gg.y); o.z = f2bf(v[i].z * rstd * gg.z); o.w = f2bf(v[i].w * rstd * gg.w);
            ((ushort4*)(dst + (size_t)r * D))[lane + 64 * i] = o;
        }
    }
}

template <bool DUAL, class Epi>
DI void ngemm(const bf16_t* A, int lda, const int* rowlist, int M, const bf16_t* Bt, int ldb, int N, int K, const Epi& epi, char* smem, int rot) {
    float* As = (float*)smem;
    float* Bs = As + 32 * 132;
    float* Bs2 = Bs + 32 * 68;
    const int tid = threadIdx.x, ty = tid >> 4, tx = tid & 15;
    const int nmt = (M + 127) / 128, nnt = N / 64, nu = nmt * nnt;
    const int G = gridDim.x; int b0 = (int)blockIdx.x - (rot % G); if (b0 < 0) b0 += G;
    for (int u = b0; u < nu; u += G) {
        const int mt = u % nmt, ntile = u / nmt, m0 = mt * 128, n0 = ntile * 64;
        float acc[4][4], acc2[4][4];
#pragma unroll
        for (int i = 0; i < 4; ++i)
#pragma unroll
            for (int j = 0; j < 4; ++j) { acc[i][j] = 0.f; acc2[i][j] = 0.f; }
        const int ar = tid >> 2, akc = (tid & 3) * 8; const int am = m0 + ar; const bool aval = am < M;
        const size_t arow = aval ? (size_t)(rowlist ? rowlist[am] : am) : 0;
        const int br = tid >> 3, bkc = (tid & 7) * 4; const int bn = n0 + br;
        const size_t brow = DUAL ? (size_t)((bn >> 7) * 256 + (bn & 127)) : (size_t)bn;
        for (int k0 = 0; k0 < K; k0 += 32) {
            uint4 av = make_uint4(0, 0, 0, 0);
            if (aval) av = *(const uint4*)(A + arow * lda + k0 + akc);
            const uint2 bv = *(const uint2*)(Bt + brow * ldb + k0 + bkc);
            uint2 bv2 = make_uint2(0, 0);
            if (DUAL) bv2 = *(const uint2*)(Bt + (brow + 128) * ldb + k0 + bkc);
            const unsigned aw[4] = {av.x, av.y, av.z, av.w};
#pragma unroll
            for (int j = 0; j < 4; ++j) { As[(akc + 2 * j) * 132 + ar] = __uint_as_float(aw[j] << 16); As[(akc + 2 * j + 1) * 132 + ar] = __uint_as_float(aw[j] & 0xffff0000u); }
            Bs[(bkc + 0) * 68 + br] = __uint_as_float(bv.x << 16); Bs[(bkc + 1) * 68 + br] = __uint_as_float(bv.x & 0xffff0000u);
            Bs[(bkc + 2) * 68 + br] = __uint_as_float(bv.y << 16); Bs[(bkc + 3) * 68 + br] = __uint_as_float(bv.y & 0xffff0000u);
            if (DUAL) {
                Bs2[(bkc + 0) * 68 + br] = __uint_as_float(bv2.x << 16); Bs2[(bkc + 1) * 68 + br] = __uint_as_float(bv2.x & 0xffff0000u);
                Bs2[(bkc + 2) * 68 + br] = __uint_as_float(bv2.y << 16); Bs2[(bkc + 3) * 68 + br] = __uint_as_float(bv2.y & 0xffff0000u);
            }
            __syncthreads();
#pragma unroll 8
            for (int kk = 0; kk < 32; ++kk) {
                const float4 a = *(const float4*)(As + kk * 132 + ty * 4);
                const float4 b = *(const float4*)(Bs + kk * 68 + tx * 4);
                const float aa[4] = {a.x, a.y, a.z, a.w}, bb[4] = {b.x, b.y, b.z, b.w};
#pragma unroll
                for (int i = 0; i < 4; ++i)
#pragma unroll
                    for (int j = 0; j < 4; ++j) acc[i][j] += aa[i] * bb[j];
                if (DUAL) {
                    const float4 b2 = *(const float4*)(Bs2 + kk * 68 + tx * 4);
                    const float bb2[4] = {b2.x, b2.y, b2.z, b2.w};
#pragma unroll
                    for (int i = 0; i < 4; ++i)
#pragma unroll
                        for (int j = 0; j < 4; ++j) acc2[i][j] += aa[i] * bb2[j];
                }
            }
            __syncthreads();
        }
#pragma unroll
        for (int i = 0; i < 4; ++i) {
            const int m = m0 + ty * 4 + i;
            if (m < M) {
#pragma unroll
                for (int j = 0; j < 4; ++j) epi(m, n0 + tx * 4 + j, acc[i][j], acc2[i][j]);
            }
        }
    }
}

template <int NK, int NQ, class EnumF, class KPtrF, class VPtrF>
DI void wave_attn(float* wl, const float (&qv)[NQ], const EnumF& en, const KPtrF& kp, const VPtrF& vp, bf16_t* outp) {
    const int lane = threadIdx.x & 63;
    float* qs = wl; float* sc = wl + NQ * 64; int* kt = (int*)(sc + NK);
#pragma unroll
    for (int g = 0; g < NQ; ++g) qs[g * 64 + lane] = qv[g];
    wave_lds_sync();
    float mx = -3.0e38f;
    for (int i = lane; i < NK; i += 64) {
        int key, qsel; float bias;
        const bool valid = en(i, key, bias, qsel);
        float s = -3.0e38f;
        if (valid) {
            const uint4* kr = (const uint4*)kp(key);
            float d = 0.f;
#pragma unroll
            for (int c8 = 0; c8 < 8; ++c8) {
                const uint4 kv = kr[c8]; const unsigned w[4] = {kv.x, kv.y, kv.z, kv.w};
#pragma unroll
                for (int j = 0; j < 4; ++j) { d += qs[qsel * 64 + c8 * 8 + 2 * j] * __uint_as_float(w[j] << 16); d += qs[qsel * 64 + c8 * 8 + 2 * j + 1] * __uint_as_float(w[j] & 0xffff0000u); }
            }
            s = d * 0.125f + bias;
        }
        sc[i] = s; kt[i] = valid ? key : -1;
        mx = fmaxf(mx, s);
    }
    mx = wave_max(mx);
    float sum = 0.f;
    for (int i = lane; i < NK; i += 64) { const float s = sc[i]; const float pe = (kt[i] >= 0) ? __expf(s - mx) : 0.f; sc[i] = pe; sum += pe; }
    sum = wave_sum(sum);
    wave_lds_sync();
    float o = 0.f;
    for (int i = 0; i < NK; ++i) {
        const int key = kt[i];
        if (key >= 0) o += sc[i] * bf2f(vp(key)[lane]);
    }
    outp[lane] = f2bf(o / sum);
    wave_lds_sync();
}

constexpr int NPH = 20;

DI void ph_prologue(const P& p, char* smem) {
    float* sm = (float*)smem;
    conv_job(p.e_w_in, nullptr, A_IN, D, A_IN, p.Wt_in0, 0, sm);
    conv_job(p.e_w_gate, p.e_w_up, FF0, D, 2 * FF0, p.Wt_gu0, 1, sm);
    conv_job(p.e_w_down, nullptr, D, FF0, D, p.Wt_down0, 0, sm);
    conv_job(p.w_out, nullptr, D, OUT_IN, D, p.Wt_out, 0, sm);
    conv_job(p.w_out + (size_t)OUT_IN * D, nullptr, D, OUT_IN, D, p.Wt_out + (size_t)D * OUT_IN, 0, sm);
    conv_job(p.o_w_in, nullptr, 2120, D, B_INP, p.Wt_in1, 2, sm);
    conv_job(p.w_mem_kv, nullptr, 512, D, 512, p.Wt_memkv, 0, sm);
    conv_job(p.w_mem_kv + (size_t)D * 512, nullptr, 512, D, 512, p.Wt_memkv + (size_t)512 * D, 0, sm);
    conv_job(p.o_w_uk, nullptr, 1024, 256, 1024, p.Wt_ukv, 0, sm);
    conv_job(p.o_w_uv, nullptr, 1024, 256, 1024, p.Wt_ukv + (size_t)1024 * 256, 0, sm);
    for (int e = 0; e < NE; ++e) {
        conv_job(p.o_w_gate + (size_t)e * D * FF1, p.o_w_up + (size_t)e * D * FF1, FF1, D, 2 * FF1, p.Wt_gu1 + (size_t)e * 2 * FF1 * D, 1, sm);
        conv_job(p.o_w_down + (size_t)e * FF1 * D, nullptr, D, FF1, D, p.Wt_down1 + (size_t)e * D * FF1, 0, sm);
    }
    for (int i = blockIdx.x * NTHR + threadIdx.x; i < 2049 * 16; i += gridDim.x * NTHR) {
        const int dist = i >> 4, hh = i & 15; int bucket;
        if (dist < 16) bucket = dist;
        else { const float nf = (float)dist; int lg = 16 + (int)(logf(nf / 16.0f) / logf(128.0f) * 16.0f); bucket = lg < 31 ? lg : 31; }
        p.biasd[i] = p.rel_bias[bucket * 16 + hh];
    }
    rms_rows_bf16(p.mem, B * NMEM, p.mem_norm, p.memn);
    rms_rows_bf16(p.x, T, p.mixer_norm, p.h);
}

struct EpiStoreBf16 { bf16_t* O; int ldo; DI void operator()(int m, int n, float v, float) const { O[(size_t)m * ldo + n] = f2bf(v); } };
struct EpiResid { const float* base; float* out; DI void operator()(int m, int n, float v, float) const { out[(size_t)m * D + n] = base[(size_t)m * D + n] + v; } };
struct EpiSwiglu { bf16_t* O; int ldo; DI void operator()(int m, int n, float g, float u) const { const float s = g / (1.0f + __expf(-g)); O[(size_t)m * ldo + n] = f2bf(s * u); } };
struct EpiSwigluRows { bf16_t* O; int ldo; int rowoff; DI void operator()(int m, int n, float g, float u) const { const float s = g / (1.0f + __expf(-g)); O[(size_t)(rowoff + m) * ldo + n] = f2bf(s * u); } };

DI void ph_proj0(const P& p, char* smem) {
    for (int i = 0; i < 2; ++i) {
        EpiStoreBf16 e{p.kvmem + (size_t)i * B * NMEM * 512, 512};
        ngemm<false>(p.memn, D, nullptr, B * NMEM, p.Wt_memkv + (size_t)i * 512 * D, D, 512, D, e, smem, i * 128);
    }
    EpiStoreBf16 e{(bf16_t*)(p.rb + RB_PROJ0), A_IN};
    ngemm<false>(p.h, D, nullptr, T, p.Wt_in0, D, A_IN, D, e, smem, 0);
}

DI void cross_attn(const P& p, int li, const bf16_t* proj, int ldp, int qoff, float* wl) {
    const int lane = threadIdx.x & 63, gw = blockIdx.x * NWAVE + (threadIdx.x >> 6), nw = gridDim.x * NWAVE;
    bf16_t* mixcat = (bf16_t*)(p.rb + RB_MIXCAT);
    const bf16_t* kvm = p.kvmem + (size_t)li * B * NMEM * 512;
    for (int w = gw; w < T * 4; w += nw) {
        const int t = w >> 2, hd = w & 3, b = t / S;
        float qv[1] = {bf2f(proj[(size_t)t * ldp + qoff + hd * 64 + lane])};
        const bf16_t* kb = kvm + (size_t)b * NMEM * 512 + hd * 64;
        auto en = [&](int i, int& key, float& bias, int& qsel) { key = i; bias = 0.f; qsel = 0; return true; };
        auto kp = [&](int key) { return kb + (size_t)key * 512; };
        auto vp = [&](int key) { return kb + (size_t)key * 512 + 256; };
        wave_attn<256, 1>(wl, qv, en, kp, vp, mixcat + (size_t)t * OUT_IN + 1024 + hd * 64);
    }
}

DI void ph_attn0(const P& p, char* smem) {
    const int lane = threadIdx.x & 63, wid = threadIdx.x >> 6, gw = blockIdx.x * NWAVE + wid, nw = gridDim.x * NWAVE;
    float* wl = (float*)smem + wid * 1024;
    const bf16_t* proj0 = (const bf16_t*)(p.rb + RB_PROJ0);
    bf16_t* mixcat = (bf16_t*)(p.rb + RB_MIXCAT);
    for (int w = gw; w < T * 16; w += nw) {
        const int t = w >> 4, hd = w & 15, b = t / S, tl = t % S;
        float qv[3];
#pragma unroll
        for (int g = 0; g < 3; ++g) qv[g] = bf2f(proj0[(size_t)t * A_IN + g * 1024 + hd * 64 + lane]);
        const bf16_t* base = proj0 + (size_t)b * S * A_IN + hd * 64;
        const float* bd = p.biasd + hd;
        auto en = [&](int i, int& key, float& bias, int& qsel) {
            const int g = i / 129, j = i - g * 129, d = (g == 0) ? 1 : (g == 1 ? 4 : 16);
            key = tl - j * d; qsel = g; bias = bd[(j * d) * 16];
            return key >= 0;
        };
        auto kp = [&](int key) { return base + (size_t)key * A_IN + P0_K; };
        auto vp = [&](int key) { return base + (size_t)key * A_IN + P0_V; };
        wave_attn<387, 3>(wl, qv, en, kp, vp, mixcat + (size_t)t * OUT_IN + hd * 64);
    }
    cross_attn(p, 0, proj0, A_IN, P0_QC, wl);
}

DI void ph_outproj(const P& p, int li, char* smem) {
    EpiResid e{li == 0 ? p.x : p.out, p.out};
    ngemm<false>((const bf16_t*)(p.rb + RB_MIXCAT), OUT_IN, nullptr, T, p.Wt_out + (size_t)li * D * OUT_IN, OUT_IN, D, OUT_IN, e, smem, 0);
}

DI void ph_gateup0(const P& p, char* smem) {
    EpiSwiglu e{(bf16_t*)(p.rb + RB_ACT0), FF0};
    ngemm<true>(p.h, D, nullptr, T, p.Wt_gu0, D, FF0, D, e, smem, 0);
}
DI void ph_down0(const P& p, char* smem) {
    EpiResid e{p.out, p.out};
    ngemm<false>((const bf16_t*)(p.rb + RB_ACT0), FF0, nullptr, T, p.Wt_down0, FF0, D, FF0, e, smem, 0);
}

DI void ph_proj1(const P& p, char* smem) {
    EpiStoreBf16 e{(bf16_t*)(p.rb + RB_PROJ1), B_INP};
    ngemm<false>(p.h, D, nullptr, T, p.Wt_in1, D, B_INP, D, e, smem, 0);
}

DI void ph_ckvnorm(const P& p) {
    const int lane = threadIdx.x & 63, gw = blockIdx.x * NWAVE + (threadIdx.x >> 6), nw = gridDim.x * NWAVE;
    const bf16_t* proj1 = (const bf16_t*)(p.rb + RB_PROJ1); bf16_t* ckv = (bf16_t*)(p.rb + RB_CKV);
    for (int t = gw; t < T; t += nw) {
        const ushort4 r = *(const ushort4*)(proj1 + (size_t)t * B_INP + P1_CKV + lane * 4);
        const float v0 = bf2f(r.x), v1 = bf2f(r.y), v2 = bf2f(r.z), v3 = bf2f(r.w);
        const float ss = wave_sum(v0 * v0 + v1 * v1 + v2 * v2 + v3 * v3);
        const float rstd = rsqrtf(ss * (1.0f / 256.0f) + 1e-6f);
        const float4 g = *(const float4*)(p.o_kv_norm + lane * 4);
        ushort4 o; o.x = f2bf(v0 * rstd * g.x); o.y = f2bf(v1 * rstd * g.y); o.z = f2bf(v2 * rstd * g.z); o.w = f2bf(v3 * rstd * g.w);
        *(ushort4*)(ckv + (size_t)t * 256 + lane * 4) = o;
    }
}

DI void ph_kvfull(const P& p, char* smem) {
    EpiStoreBf16 e{(bf16_t*)(p.rb + RB_KVFULL), 2048};
    ngemm<false>((const bf16_t*)(p.rb + RB_CKV), 256, nullptr, T, p.Wt_ukv, 256, 2048, 256, e, smem, 0);
}

DI void ph_topk(const P& p, char* smem) {
    float* sc = (float*)smem;
    bf16_t* qsm = (bf16_t*)(smem + 131072);
    float* wsm = (float*)(smem + 131072 + 16384);
    const int tid = threadIdx.x, lane = tid & 63, wid = tid >> 6;
    const bf16_t* proj1 = (const bf16_t*)(p.rb + RB_PROJ1);
    unsigned* bitmask = (unsigned*)(p.rb + RB_BITMASK); unsigned short* idxl = (unsigned short*)(p.rb + RB_IDX);
    for (int u = blockIdx.x; u < T / 16; u += gridDim.x) {
        const int t0 = u * 16, b = t0 / S, tl0 = t0 % S, tmax = tl0 + 15;
        for (int i = tid; i < 16 * 64; i += NTHR) { const int qi = i >> 6, c8 = i & 63; *(uint4*)(qsm + qi * 512 + c8 * 8) = *(const uint4*)(proj1 + (size_t)(t0 + qi) * B_INP + P1_QIDX + c8 * 8); }
        if (tid < 128) wsm[tid] = bf2f(proj1[(size_t)(t0 + (tid >> 3)) * B_INP + P1_WIDX + (tid & 7)]) * 0.35355339059327373f;
        __syncthreads();
        for (int s = tid; s <= tmax; s += NTHR) {
            float k[64];
            const uint4* kr = (const uint4*)(proj1 + (size_t)(b * S + s) * B_INP + P1_KIDX);
#pragma unroll
            for (int c8 = 0; c8 < 8; ++c8) { const uint4 kv = kr[c8]; const unsigned w[4] = {kv.x, kv.y, kv.z, kv.w};
#pragma unroll
                for (int j = 0; j < 4; ++j) { k[c8 * 8 + 2 * j] = __uint_as_float(w[j] << 16); k[c8 * 8 + 2 * j + 1] = __uint_as_float(w[j] & 0xffff0000u); } }
#pragma unroll 1
            for (int qi = 0; qi < 16; ++qi) {
                float tot = 0.f;
#pragma unroll 1
                for (int hh = 0; hh < 8; ++hh) {
                    const uint4* qr = (const uint4*)(qsm + qi * 512 + hh * 64);
                    float d = 0.f;
#pragma unroll
                    for (int c8 = 0; c8 < 8; ++c8) { const uint4 qv = qr[c8]; const unsigned w[4] = {qv.x, qv.y, qv.z, qv.w};
#pragma unroll
                        for (int j = 0; j < 4; ++j) { d += __uint_as_float(w[j] << 16) * k[c8 * 8 + 2 * j]; d += __uint_as_float(w[j] & 0xffff0000u) * k[c8 * 8 + 2 * j + 1]; } }
                    tot += wsm[qi * 8 + hh] * fmaxf(d * 0.125f, 0.f);
                }
                sc[qi * 2048 + s] = tot + 0.0f;
            }
        }
        __syncthreads();
#pragma unroll 1
        for (int rr = 0; rr < 2; ++rr) {
            const int qi = wid * 2 + rr, t = t0 + qi, tl = tl0 + qi;
            unsigned uu[32];
#pragma unroll
            for (int i = 0; i < 32; ++i) {
                const int key = lane + 64 * i;
                unsigned v = 0u;
                if (key <= tl) { const unsigned bits = __float_as_uint(sc[qi * 2048 + key]); v = (bits & 0x80000000u) ? ~bits : (bits | 0x80000000u); }
                uu[i] = v;
            }
            unsigned T_ = 0u; int need_eq = 0; bool all_causal = (tl + 1 <= 256);
            if (!all_causal) {
                unsigned v = 0u; bool exact = false;
#pragma unroll 1
                for (int bit = 31; bit >= 0; --bit) {
                    const unsigned cand = v | (1u << bit);
                    int cnt = 0;
#pragma unroll
                    for (int i = 0; i < 32; ++i) cnt += __builtin_popcountll(__ballot(uu[i] >= cand));
                    if (cnt >= 256) { v = cand; if (cnt == 256) { exact = true; break; } }
                }
                T_ = v;
                if (!exact) {
                    int ngt = 0;
#pragma unroll
                    for (int i = 0; i < 32; ++i) ngt += __builtin_popcountll(__ballot(uu[i] > T_));
                    need_eq = 256 - ngt;
                } else need_eq = -1;
            }
            unsigned myword = 0u; int taken = 0, off = 0;
#pragma unroll
            for (int i = 0; i < 32; ++i) {
                const int key = lane + 64 * i;
                unsigned long long m;
                if (all_causal) m = __ballot(key <= tl);
                else if (need_eq < 0) m = __ballot(uu[i] >= T_);
                else {
                    const unsigned long long g = __ballot(uu[i] > T_); unsigned long long e = __ballot(uu[i] == T_);
                    const int c = __builtin_popcountll(e);
                    if (taken + c > need_eq) { unsigned long long sel = 0ull; int k2 = need_eq - taken; while (k2 > 0) { const unsigned long long low = e & (0ull - e); sel |= low; e ^= low; --k2; } e = sel; taken = need_eq; }
                    else taken += c;
                    m = g | e;
                }
                if (lane == 2 * i) myword = (unsigned)m;
                if (lane == 2 * i + 1) myword = (unsigned)(m >> 32);
                if ((m >> lane) & 1ull) { const int rank = __builtin_popcountll(m & ((1ull << lane) - 1ull)); idxl[(size_t)t * 256 + off + rank] = (unsigned short)key; }
                off += __builtin_popcountll(m);
            }
            bitmask[(size_t)t * 64 + lane] = myword;
            for (int e2 = off + lane; e2 < 256; e2 += 64) idxl[(size_t)t * 256 + e2] = 0xFFFFu;
        }
        __syncthreads();
    }
}

DI void ph_attn1(const P& p, char* smem) {
    const int lane = threadIdx.x & 63, wid = threadIdx.x >> 6, gw = blockIdx.x * NWAVE + wid, nw = gridDim.x * NWAVE;
    float* wl = (float*)smem + wid * 1024;
    const bf16_t* proj1 = (const bf16_t*)(p.rb + RB_PROJ1); const bf16_t* kvfull = (const bf16_t*)(p.rb + RB_KVFULL);
    const unsigned short* idxl = (const unsigned short*)(p.rb + RB_IDX);
    bf16_t* mixcat = (bf16_t*)(p.rb + RB_MIXCAT);
    for (int w = gw; w < T * 16; w += nw) {
        const int t = w >> 4, hd = w & 15, b = t / S, tl = t % S;
        float qv[1] = {bf2f(proj1[(size_t)t * B_INP + P1_Q + hd * 64 + lane])};
        const bf16_t* base = kvfull + (size_t)b * S * 2048 + hd * 64;
        const unsigned short* il = idxl + (size_t)t * 256;
        const float* bd = p.biasd + hd;
        auto en = [&](int i, int& key, float& bias, int& qsel) {
            const int k = il[i]; key = k; qsel = 0;
            const bool valid = (k <= tl);
            bias = valid ? bd[(tl - k) * 16] : 0.f;
            return valid;
        };
        auto kp = [&](int key) { return base + (size_t)key * 2048; };
        auto vp = [&](int key) { return base + (size_t)key * 2048 + 1024; };
        wave_attn<256, 1>(wl, qv, en, kp, vp, mixcat + (size_t)t * OUT_IN + hd * 64);
    }
    cross_attn(p, 1, proj1, B_INP, P1_QC, wl);
}

DI void ph_router(const P& p) {
    const int lane = threadIdx.x & 63, gw = blockIdx.x * NWAVE + (threadIdx.x >> 6), nw = gridDim.x * NWAVE;
    const int Tc = T / p.nsplit;
    const float* g = p.ffn_norm + D;
    for (int t = gw; t < T; t += nw) {
        const float4* s = (const float4*)(p.out + (size_t)t * D);
        float4 v[4]; float ss = 0.f;
#pragma unroll
        for (int i = 0; i < 4; ++i) { v[i] = s[lane + 64 * i]; ss += v[i].x * v[i].x + v[i].y * v[i].y + v[i].z * v[i].z + v[i].w * v[i].w; }
        ss = wave_sum(ss);
        const float rstd = rsqrtf(ss * (1.0f / D) + 1e-6f);
        float lg[8];
#pragma unroll
        for (int e = 0; e < 8; ++e) lg[e] = 0.f;
#pragma unroll
        for (int i = 0; i < 4; ++i) {
            const float4 gg = ((const float4*)g)[lane + 64 * i];
            const float hv[4] = {v[i].x * rstd * gg.x, v[i].y * rstd * gg.y, v[i].z * rstd * gg.z, v[i].w * rstd * gg.w};
            ushort4 o; o.x = f2bf(hv[0]); o.y = f2bf(hv[1]); o.z = f2bf(hv[2]); o.w = f2bf(hv[3]);
            ((ushort4*)(p.h + (size_t)t * D))[lane + 64 * i] = o;
#pragma unroll
            for (int j = 0; j < 4; ++j) {
                const int k = (lane + 64 * i) * 4 + j;
                const float4 w0 = *(const float4*)(p.o_w_router + (size_t)k * 8), w1 = *(const float4*)(p.o_w_router + (size_t)k * 8 + 4);
                lg[0] += hv[j] * w0.x; lg[1] += hv[j] * w0.y; lg[2] += hv[j] * w0.z; lg[3] += hv[j] * w0.w;
                lg[4] += hv[j] * w1.x; lg[5] += hv[j] * w1.y; lg[6] += hv[j] * w1.z; lg[7] += hv[j] * w1.w;
            }
        }
#pragma unroll
        for (int e = 0; e < 8; ++e) lg[e] = wave_sum(lg[e]);
        if (lane == 0) {
            int e1 = 0; float v1 = lg[0];
#pragma unroll
            for (int e = 1; e < 8; ++e) if (lg[e] > v1) { v1 = lg[e]; e1 = e; }
            int e2 = -1; float v2 = -3.0e38f;
#pragma unroll
            for (int e = 0; e < 8; ++e) if (e != e1 && lg[e] > v2) { v2 = lg[e]; e2 = e; }
            const float ex = __expf(v2 - v1); const float g1 = 1.0f / (1.0f + ex), g2 = ex / (1.0f + ex);
            const int c = t / Tc;
            const int p1 = (int)atomicAdd(p.ctl + CTL_CNT + c * 8 + e1, 1u), p2 = (int)atomicAdd(p.ctl + CTL_CNT + c * 8 + e2, 1u);
            p.lists[((size_t)c * 8 + e1) * Tc + p1] = t; p.lists[((size_t)c * 8 + e2) * Tc + p2] = t;
            p.tok_e[t * 2] = e1; p.tok_e[t * 2 + 1] = e2; p.tok_pos[t * 2] = p1; p.tok_pos[t * 2 + 1] = p2; p.tok_g[t * 2] = g1; p.tok_g[t * 2 + 1] = g2;
        }
    }
}

DI void moe_offsets(const P& p, int c, int (&cnt)[8], int (&off)[8]) {
    int o = 0;
#pragma unroll
    for (int e = 0; e < 8; ++e) { cnt[e] = (int)p.ctl[CTL_CNT + c * 8 + e]; off[e] = o; o += (cnt[e] + 255) & ~255; }
}
DI size_t moe_rowcap(const P& p) { return (size_t)(2 * (T / p.nsplit) + 2048); }

DI void ph_moe_gateup(const P& p, int c, char* smem) {
    int cnt[8], off[8]; moe_offsets(p, c, cnt, off);
    const int Tc = T / p.nsplit;
    bf16_t* act1 = (bf16_t*)p.rb;
    for (int e = 0; e < 8; ++e) {
        EpiSwigluRows ep{act1, FF1, off[e]};
        ngemm<true>(p.h, D, p.lists + ((size_t)c * 8 + e) * Tc, cnt[e], p.Wt_gu1 + (size_t)e * 2 * FF1 * D, D, FF1, D, ep, smem, e * 37);
    }
}
struct EpiStoreRows { bf16_t* O; int rowoff; DI void operator()(int m, int n, float v, float) const { O[(size_t)(rowoff + m) * D + n] = f2bf(v); } };
DI void ph_moe_down(const P& p, int c, char* smem) {
    int cnt[8], off[8]; moe_offsets(p, c, cnt, off);
    const bf16_t* act1 = (const bf16_t*)p.rb; bf16_t* ybuf = (bf16_t*)(p.rb + moe_rowcap(p) * FF1 * 2);
    for (int e = 0; e < 8; ++e) {
        EpiStoreRows ep{ybuf, off[e]};
        ngemm<false>(act1 + (size_t)off[e] * FF1, FF1, nullptr, cnt[e], p.Wt_down1 + (size_t)e * D * FF1, FF1, D, FF1, ep, smem, e * 37);
    }
}
DI void ph_moe_combine(const P& p, int c) {
    int cnt[8], off[8]; moe_offsets(p, c, cnt, off);
    const int Tc = T / p.nsplit;
    const bf16_t* ybuf = (const bf16_t*)(p.rb + moe_rowcap(p) * FF1 * 2);
    const int lane = threadIdx.x & 63, gw = blockIdx.x * NWAVE + (threadIdx.x >> 6), nw = gridDim.x * NWAVE;
    for (int tt = gw; tt < Tc; tt += nw) {
        const int t = c * Tc + tt;
        const int e1 = p.tok_e[t * 2], e2 = p.tok_e[t * 2 + 1]; const float g1 = p.tok_g[t * 2], g2 = p.tok_g[t * 2 + 1];
        int o1 = 0, o2 = 0;
#pragma unroll
        for (int e = 0; e < 8; ++e) { if (e == e1) o1 = off[e]; if (e == e2) o2 = off[e]; }
        const bf16_t* y1 = ybuf + (size_t)(o1 + p.tok_pos[t * 2]) * D; const bf16_t* y2 = ybuf + (size_t)(o2 + p.tok_pos[t * 2 + 1]) * D;
        float4* xo = (float4*)(p.out + (size_t)t * D);
        float4 v[4]; float ss = 0.f;
#pragma unroll
        for (int i = 0; i < 4; ++i) {
            v[i] = xo[lane + 64 * i];
            const ushort4 a = ((const ushort4*)y1)[lane + 64 * i], bq = ((const ushort4*)y2)[lane + 64 * i];
            v[i].x += g1 * bf2f(a.x) + g2 * bf2f(bq.x); v[i].y += g1 * bf2f(a.y) + g2 * bf2f(bq.y); v[i].z += g1 * bf2f(a.z) + g2 * bf2f(bq.z); v[i].w += g1 * bf2f(a.w) + g2 * bf2f(bq.w);
            ss += v[i].x * v[i].x + v[i].y * v[i].y + v[i].z * v[i].z + v[i].w * v[i].w;
        }
        ss = wave_sum(ss);
        const float rstd = rsqrtf(ss * (1.0f / D) + 1e-6f);
#pragma unroll
        for (int i = 0; i < 4; ++i) {
            const float4 gg = ((const float4*)p.final_norm)[lane + 64 * i];
            xo[lane + 64 * i] = make_float4(v[i].x * rstd * gg.x, v[i].y * rstd * gg.y, v[i].z * rstd * gg.z, v[i].w * rstd * gg.w);
        }
    }
}

enum { PH_PRO = 0, PH_PROJ0, PH_ATTN0, PH_OUT0, PH_NORM_F0, PH_GU0, PH_DOWN0, PH_NORM_M1, PH_PROJ1, PH_CKV, PH_KVFULL, PH_TOPK, PH_ATTN1, PH_OUT1, PH_ROUTER, PH_MOE0 };

__global__ void __launch_bounds__(NTHR, 2) fwd(P p) {
    extern __shared__ __attribute__((aligned(16))) unsigned char lds[];
    char* smem = (char*)lds;
    const int lo = p.ph_lo, hi = p.ph_hi;
#define IN(k) (lo <= (k) && (k) < hi)
    if (IN(PH_PRO)) ph_prologue(p, smem);
    if (IN(PH_PROJ0)) ph_proj0(p, smem);
    if (IN(PH_ATTN0)) ph_attn0(p, smem);
    if (IN(PH_OUT0)) ph_outproj(p, 0, smem);
    if (IN(PH_NORM_F0)) rms_rows_bf16(p.out, T, p.ffn_norm, p.h);
    if (IN(PH_GU0)) ph_gateup0(p, smem);
    if (IN(PH_DOWN0)) ph_down0(p, smem);
    if (IN(PH_NORM_M1)) rms_rows_bf16(p.out, T, p.mixer_norm + D, p.h);
    if (IN(PH_PROJ1)) ph_proj1(p, smem);
    if (IN(PH_CKV)) ph_ckvnorm(p);
    if (IN(PH_KVFULL)) ph_kvfull(p, smem);
    if (IN(PH_TOPK)) ph_topk(p, smem);
    if (IN(PH_ATTN1)) ph_attn1(p, smem);
    if (IN(PH_OUT1)) ph_outproj(p, 1, smem);
    if (IN(PH_ROUTER)) ph_router(p);
    for (int c = 0; c < p.nsplit; ++c) {
        const int base = PH_MOE0 + 3 * c;
        if (IN(base)) ph_moe_gateup(p, c, smem);
        if (IN(base + 1)) ph_moe_down(p, c, smem);
        if (IN(base + 2)) ph_moe_combine(p, c);
    }
#undef IN
}

static size_t align_up(size_t v, size_t a) { return (v + a - 1) / a * a; }

extern "C" void kernel_launch(void* const* d_in, const int* in_sizes, int n_in, void* d_out, int out_size, void* d_ws, size_t ws_size, hipStream_t stream) {
    (void)in_sizes; (void)n_in; (void)out_size;
    P p{};
    p.x = (const float*)d_in[0]; p.mem = (const float*)d_in[1]; p.rel_bias = (const float*)d_in[2]; p.mem_norm = (const float*)d_in[3];
    p.final_norm = (const float*)d_in[4]; p.mixer_norm = (const float*)d_in[5]; p.ffn_norm = (const float*)d_in[6]; p.w_mem_kv = (const float*)d_in[7];
    p.w_out = (const float*)d_in[8]; p.e_w_in = (const float*)d_in[9]; p.e_w_gate = (const float*)d_in[10]; p.e_w_up = (const float*)d_in[11];
    p.e_w_down = (const float*)d_in[12]; p.o_w_in = (const float*)d_in[13]; p.o_kv_norm = (const float*)d_in[14]; p.o_w_uk = (const float*)d_in[15];
    p.o_w_uv = (const float*)d_in[16]; p.o_w_router = (const float*)d_in[17]; p.o_w_gate = (const float*)d_in[18]; p.o_w_up = (const float*)d_in[19];
    p.o_w_down = (const float*)d_in[20];
    p.out = (float*)d_out;
    char* ws = (char*)d_ws; size_t o = 0;
    auto take = [&](size_t bytes) { char* r = ws + o; o = align_up(o + bytes, 256); return r; };
    p.ctl = (unsigned*)take(CTL_WORDS * 4);
    p.biasd = (float*)take(2049 * 16 * 4);
    p.Wt_in0 = (bf16_t*)take((size_t)A_IN * D * 2);
    p.Wt_gu0 = (bf16_t*)take((size_t)2 * FF0 * D * 2);
    p.Wt_down0 = (bf16_t*)take((size_t)D * FF0 * 2);
    p.Wt_out = (bf16_t*)take((size_t)2 * D * OUT_IN * 2);
    p.Wt_in1 = (bf16_t*)take((size_t)B_INP * D * 2);
    p.Wt_memkv = (bf16_t*)take((size_t)2 * 512 * D * 2);
    p.Wt_ukv = (bf16_t*)take((size_t)2048 * 256 * 2);
    p.Wt_gu1 = (bf16_t*)take((size_t)NE * 2 * FF1 * D * 2);
    p.Wt_down1 = (bf16_t*)take((size_t)NE * D * FF1 * 2);
    p.memn = (bf16_t*)take((size_t)B * NMEM * D * 2);
    p.kvmem = (bf16_t*)take((size_t)2 * B * NMEM * 512 * 2);
    p.h = (bf16_t*)take((size_t)T * D * 2);
    p.tok_e = (int*)take((size_t)T * 2 * 4); p.tok_pos = (int*)take((size_t)T * 2 * 4); p.tok_g = (float*)take((size_t)T * 2 * 4);
    p.lists = (int*)take((size_t)NE * T * 4);
    p.rb = take(0);
    const size_t fixed = o;
    int nsplit = 1;
    for (; nsplit <= 8; nsplit *= 2) {
        const size_t rowcap = (size_t)(2 * (T / nsplit) + 2048);
        size_t need = rowcap * FF1 * 2 + rowcap * D * 2; if (need < RB_MIN) need = RB_MIN;
        if (fixed + need <= ws_size) break;
    }
    if (nsplit > 8) { fprintf(stderr, "kernel_launch: workspace too small (%zu)\n", ws_size); return; }
    p.nsplit = nsplit;
    static bool attr = false;
    if (!attr) { (void)hipFuncSetAttribute((const void*)fwd, hipFuncAttributeMaxDynamicSharedMemorySize, LDS_BYTES); attr = true; }
    (void)hipMemsetAsync(p.ctl, 0, CTL_WORDS * 4, stream);
    const int nph = PH_MOE0 + 3 * nsplit;
    for (int ph = 0; ph < nph; ++ph) {
        p.ph_lo = ph; p.ph_hi = ph + 1;
        hipLaunchKernelGGL(fwd, dim3(1024), dim3(NTHR), LDS_BYTES, stream, p);
    }
}
```

```cpp
#include <hip/hip_runtime.h>
#include <stdint.h>
#include <stdio.h>

typedef unsigned short bf16_t;
#ifndef ONE_LAUNCH
#define ONE_LAUNCH 1
#endif
#define DI __device__ __forceinline__

namespace cfg {
constexpr int B = 8, S = 2048, T = B * S, D = 1024;
constexpr int A_IN = 5376, B_INP = 2304;
constexpr int FF0 = 2816, FF1 = 3584, NE = 8;
constexpr int NMEM = 256;
constexpr int OUT_IN = 1280;
constexpr int NTHR = 512, NWAVE = 8;
constexpr int LDS_BYTES = 149504;
constexpr int P1_Q = 0, P1_CKV = 1024, P1_QIDX = 1280, P1_QC = 1792, P1_KIDX = 2048, P1_WIDX = 2112;
constexpr int P0_K = 3072, P0_V = 4096, P0_QC = 5120;
constexpr size_t RB_PROJ0 = 0, RB_MIXCAT = (size_t)T * A_IN * 2;
constexpr size_t RB_ACT0 = 0;
constexpr size_t RB_PROJ1 = 0, RB_KVFULL = (size_t)T * B_INP * 2, RB_CKV = RB_KVFULL + (size_t)T * 2048 * 2,
                 RB_BITMASK = RB_CKV + (size_t)T * 256 * 2, RB_IDX = RB_BITMASK + (size_t)T * 64 * 4, RB_L1END = RB_IDX + (size_t)T * 256 * 2;
constexpr size_t RB_MIN = RB_MIXCAT + (size_t)T * OUT_IN * 2;
static_assert(RB_L1END <= RB_MIXCAT, "layer-1 scratch overlaps mixcat");
}
using namespace cfg;

struct P {
    const float *x, *mem, *rel_bias, *mem_norm, *final_norm, *mixer_norm, *ffn_norm, *w_mem_kv, *w_out;
    const float *e_w_in, *e_w_gate, *e_w_up, *e_w_down;
    const float *o_w_in, *o_kv_norm, *o_w_uk, *o_w_uv, *o_w_router, *o_w_gate, *o_w_up, *o_w_down;
    float* out;
    unsigned* ctl;
    float* biasd;
    bf16_t *Wt_in0, *Wt_gu0, *Wt_down0, *Wt_out, *Wt_in1, *Wt_memkv, *Wt_ukv, *Wt_gu1, *Wt_down1;
    bf16_t *memn, *kvmem, *h;
    int *tok_e, *tok_pos; float* tok_g; int* lists;
    char* rb;
    int nsplit, ph_lo, ph_hi, pad;
};

constexpr int CTL_CNT = 4096;
constexpr int CTL_WORDS = 8192;

DI float bf2f(bf16_t b) { return __uint_as_float(((unsigned)b) << 16); }
DI bf16_t f2bf(float f) { unsigned u = __float_as_uint(f); u += 0x7FFFu + ((u >> 16) & 1u); return (bf16_t)(u >> 16); }
DI float wave_sum(float v) { for (int o = 32; o >= 1; o >>= 1) v += __shfl_xor(v, o); return v; }
DI float wave_max(float v) { for (int o = 32; o >= 1; o >>= 1) v = fmaxf(v, __shfl_xor(v, o)); return v; }
DI void wave_lds_sync() { asm volatile("s_waitcnt lgkmcnt(0)" ::: "memory"); __builtin_amdgcn_wave_barrier(); asm volatile("" ::: "memory"); }

DI int colmap(int mode, int n, int& which) {
    which = 0;
    if (mode == 0) return n;
    if (mode == 1) { const int j = n >> 8, r = n & 255; which = (r >= 128); return j * 128 + (r & 127); }
    if (n < 1792) return n;
    if (n < 2048) return 1864 + (n - 1792);
    if (n < 2112) return 1792 + (n - 2048);
    if (n < 2120) return 1856 + (n - 2112);
    return -1;
}
DI void conv_job(const float* s0, const float* s1, int ld, int K, int Nd, bf16_t* dst, int mode, float* sm) {
    const int tid = threadIdx.x, nk = K / 64, nn = Nd / 64, nt = nk * nn;
    for (int t = blockIdx.x; t < nt; t += gridDim.x) {
        const int tk = t % nk, tn = t / nk, k0 = tk * 64, n0 = tn * 64;
        {
            const int nl = tid & 63; int which; const int c = colmap(mode, n0 + nl, which);
            const float* s = which ? s1 : s0;
#pragma unroll
            for (int i = 0; i < 8; ++i) { const int kl = (tid >> 6) + 8 * i; sm[kl * 65 + nl] = (c >= 0) ? s[(size_t)(k0 + kl) * ld + c] : 0.f; }
        }
        __syncthreads();
        {
            const int kl = tid & 63;
#pragma unroll
            for (int i = 0; i < 8; ++i) { const int nl = (tid >> 6) + 8 * i; dst[(size_t)(n0 + nl) * K + k0 + kl] = f2bf(sm[kl * 65 + nl]); }
        }
        __syncthreads();
    }
}

DI void rms_rows_bf16(const float* src, int rows, const float* g, bf16_t* dst) {
    const int lane = threadIdx.x & 63, gw = blockIdx.x * NWAVE + (threadIdx.x >> 6), nw = gridDim.x * NWAVE;
    for (int r = gw; r < rows; r += nw) {
        const float4* s = (const float4*)(src + (size_t)r * D);
        float4 v[4]; float ss = 0.f;
#pragma unroll
        for (int i = 0; i < 4; ++i) { v[i] = s[lane + 64 * i]; ss += v[i].x * v[i].x + v[i].y * v[i].y + v[i].z * v[i].z + v[i].w * v[i].w; }
        ss = wave_sum(ss);
        const float rstd = rsqrtf(ss * (1.0f / D) + 1e-6f);
#pragma unroll
        for (int i = 0; i < 4; ++i) {
            const float4 gg = ((const float4*)g)[lane + 64 * i];
            ushort4 o; o.x = f2bf(v[i].x * rstd * gg.x); o.y = f2bf(v[i].y * rstd * gg.y); o.z = f2bf(v[i].z * rstd * gg.z); o.w = f2bf(v[i].w * rstd * gg.w);
            ((ushort4*)(dst + (size_t)r * D))[lane + 64 * i] = o;
        }
    }
}

template <bool DUAL, class Epi>
DI void ngemm(const bf16_t* A, int lda, const int* rowlist, int M, const bf16_t* Bt, int ldb, int N, int K, const Epi& epi, char* smem, int rot) {
    float* As = (float*)smem;
    float* Bs = As + 32 * 132;
    float* Bs2 = Bs + 32 * 68;
    const int tid = threadIdx.x, ty = tid >> 4, tx = tid & 15;
    const int nmt = (M + 127) / 128, nnt = N / 64, nu = nmt * nnt;
    const int G = gridDim.x; int b0 = (int)blockIdx.x - (rot % G); if (b0 < 0) b0 += G;
    for (int u = b0; u < nu; u += G) {
        const int mt = u % nmt, ntile = u / nmt, m0 = mt * 128, n0 = ntile * 64;
        float acc[4][4], acc2[4][4];
#pragma unroll
        for (int i = 0; i < 4; ++i)
#pragma unroll
            for (int j = 0; j < 4; ++j) { acc[i][j] = 0.f; acc2[i][j] = 0.f; }
        const int ar = tid >> 2, akc = (tid & 3) * 8; const int am = m0 + ar; const bool aval = am < M;
        const size_t arow = aval ? (size_t)(rowlist ? rowlist[am] : am) : 0;
        const int br = tid >> 3, bkc = (tid & 7) * 4; const int bn = n0 + br;
        const size_t brow = DUAL ? (size_t)((bn >> 7) * 256 + (bn & 127)) : (size_t)bn;
        for (int k0 = 0; k0 < K; k0 += 32) {
            uint4 av = make_uint4(0, 0, 0, 0);
            if (aval) av = *(const uint4*)(A + arow * lda + k0 + akc);
            const uint2 bv = *(const uint2*)(Bt + brow * ldb + k0 + bkc);
            uint2 bv2 = make_uint2(0, 0);
            if (DUAL) bv2 = *(const uint2*)(Bt + (brow + 128) * ldb + k0 + bkc);
            const unsigned aw[4] = {av.x, av.y, av.z, av.w};
#pragma unroll
            for (int j = 0; j < 4; ++j) { As[(akc + 2 * j) * 132 + ar] = __uint_as_float(aw[j] << 16); As[(akc + 2 * j + 1) * 132 + ar] = __uint_as_float(aw[j] & 0xffff0000u); }
            Bs[(bkc + 0) * 68 + br] = __uint_as_float(bv.x << 16); Bs[(bkc + 1) * 68 + br] = __uint_as_float(bv.x & 0xffff0000u);
            Bs[(bkc + 2) * 68 + br] = __uint_as_float(bv.y << 16); Bs[(bkc + 3) * 68 + br] = __uint_as_float(bv.y & 0xffff0000u);
            if (DUAL) {
                Bs2[(bkc + 0) * 68 + br] = __uint_as_float(bv2.x << 16); Bs2[(bkc + 1) * 68 + br] = __uint_as_float(bv2.x & 0xffff0000u);
                Bs2[(bkc + 2) * 68 + br] = __uint_as_float(bv2.y << 16); Bs2[(bkc + 3) * 68 + br] = __uint_as_float(bv2.y & 0xffff0000u);
            }
            __syncthreads();
#pragma unroll 8
            for (int kk = 0; kk < 32; ++kk) {
                const float4 a = *(const float4*)(As + kk * 132 + ty * 4);
                const float4 b = *(const float4*)(Bs + kk * 68 + tx * 4);
                const float aa[4] = {a.x, a.y, a.z, a.w}, bb[4] = {b.x, b.y, b.z, b.w};
#pragma unroll
                for (int i = 0; i < 4; ++i)
#pragma unroll
                    for (int j = 0; j < 4; ++j) acc[i][j] += aa[i] * bb[j];
                if (DUAL) {
                    const float4 b2 = *(const float4*)(Bs2 + kk * 68 + tx * 4);
                    const float bb2[4] = {b2.x, b2.y, b2.z, b2.w};
#pragma unroll
                    for (int i = 0; i < 4; ++i)
#pragma unroll
                        for (int j = 0; j < 4; ++j) acc2[i][j] += aa[i] * bb2[j];
                }
            }
            __syncthreads();
        }
#pragma unroll
        for (int i = 0; i < 4; ++i) {
            const int m = m0 + ty * 4 + i;
            if (m < M) {
#pragma unroll
                for (int j = 0; j < 4; ++j) epi(m, n0 + tx * 4 + j, acc[i][j], acc2[i][j]);
            }
        }
    }
}

template <int NK, int NQ, class EnumF, class KPtrF, class VPtrF>
DI void wave_attn(float* wl, const float (&qv)[NQ], const EnumF& en, const KPtrF& kp, const VPtrF& vp, bf16_t* outp) {
    const int lane = threadIdx.x & 63;
    float* qs = wl; float* sc = wl + NQ * 64; int* kt = (int*)(sc + NK);
#pragma unroll
    for (int g = 0; g < NQ; ++g) qs[g * 64 + lane] = qv[g];
    wave_lds_sync();
    float mx = -3.0e38f;
    for (int i = lane; i < NK; i += 64) {
        int key, qsel; float bias;
        const bool valid = en(i, key, bias, qsel);
        float s = -3.0e38f;
        if (valid) {
            const uint4* kr = (const uint4*)kp(key);
            float d = 0.f;
#pragma unroll
            for (int c8 = 0; c8 < 8; ++c8) {
                const uint4 kv = kr[c8]; const unsigned w[4] = {kv.x, kv.y, kv.z, kv.w};
#pragma unroll
                for (int j = 0; j < 4; ++j) { d += qs[qsel * 64 + c8 * 8 + 2 * j] * __uint_as_float(w[j] << 16); d += qs[qsel * 64 + c8 * 8 + 2 * j + 1] * __uint_as_float(w[j] & 0xffff0000u); }
            }
            s = d * 0.125f + bias;
        }
        sc[i] = s; kt[i] = valid ? key : -1;
        mx = fmaxf(mx, s);
    }
    mx = wave_max(mx);
    float sum = 0.f;
    for (int i = lane; i < NK; i += 64) { const float s = sc[i]; const float pe = (kt[i] >= 0) ? __expf(s - mx) : 0.f; sc[i] = pe; sum += pe; }
    sum = wave_sum(sum);
    wave_lds_sync();
    float o = 0.f;
    for (int i = 0; i < NK; ++i) {
        const int key = kt[i];
        if (key >= 0) o += sc[i] * bf2f(vp(key)[lane]);
    }
    outp[lane] = f2bf(o / sum);
    wave_lds_sync();
}


#define XB_TMO      128
#define XB_XCNT(j)  (256  + 64 * (j))
#define XB_XSUB(j)  (1280 + 64 * (j))
#define XB_XGEN(j)  (2304 + 64 * (j))
#define XB_TOP      3328
#define XB_TOPGEN   3392
#define XCD_BAR_WORDS 3456
#define XB_SPIN_CAP (1u << 20)
#define LAS __attribute__((address_space(3)))
__device__ __forceinline__ unsigned xb_ld(unsigned* p)              { return __hip_atomic_load(p, __ATOMIC_RELAXED, __HIP_MEMORY_SCOPE_AGENT); }
__device__ __forceinline__ unsigned xb_add(unsigned* p, unsigned v) { return __hip_atomic_fetch_add(p, v, __ATOMIC_RELAXED, __HIP_MEMORY_SCOPE_AGENT); }
__device__ __forceinline__ unsigned xb_xcc_id() { return (unsigned)__builtin_amdgcn_s_getreg((3 << 11) | 20) & 0xFu; }
#define XB_SPIN(cond, bar) do { unsigned _sp = 0; while (cond) { __builtin_amdgcn_s_sleep(1); \
    if ((++_sp & 255u) == 0u) { if (xb_ld(&(bar)[XB_TMO])) break; if (_sp > XB_SPIN_CAP) { atomicAdd(&(bar)[XB_TMO], 1u); break; } } } } while (0)
struct XcdBarrier { unsigned* bar; unsigned x; volatile LAS unsigned* st; };
__device__ __forceinline__ XcdBarrier xcd_barrier_post(unsigned* bar, volatile LAS unsigned* st) {
    XcdBarrier b; b.bar = bar; b.x = xb_xcc_id(); b.st = st;
    if (threadIdx.x == 0) (void)xb_add(&bar[XB_XCNT(b.x)], 1u);
    return b;
}
__device__ __forceinline__ void xcd_barrier_complete(unsigned* bar, unsigned x, unsigned& nloc, unsigned& nx) {
    const unsigned G = gridDim.x * gridDim.y * gridDim.z;
    unsigned sum, cnt, mine, sp = 0u;
    for (;;) {
        sum = 0u; cnt = 0u; mine = 0u;
#pragma unroll
        for (unsigned j = 0; j < 16; ++j) { const unsigned c = xb_ld(&bar[XB_XCNT(j)]); sum += c; cnt += (c > 0u) ? 1u : 0u; mine = (j == x) ? c : mine; }
        if (sum == G) break;
        __builtin_amdgcn_s_sleep(1);
        if ((++sp & 255u) == 0u) { if (xb_ld(&bar[XB_TMO])) break; if (sp > XB_SPIN_CAP) { atomicAdd(&bar[XB_TMO], 1u); break; } }
    }
    nloc = mine > 0u ? mine : 1u; nx = cnt > 0u ? cnt : 1u;
}
__device__ __forceinline__ void xcd_barrier(const XcdBarrier& b) {
    asm volatile("s_waitcnt vmcnt(0)" ::: "memory");
    __syncthreads();
    if (threadIdx.x == 0) {
        unsigned* bar = b.bar;
        __builtin_amdgcn_s_waitcnt(0);
        unsigned nloc = b.st[0], nx = b.st[1];
        if (nloc == 0u) { xcd_barrier_complete(bar, b.x, nloc, nx); b.st[0] = nloc; b.st[1] = nx; }
        const unsigned old = xb_add(&bar[XB_XSUB(b.x)], 1u);
        const unsigned gen = old / nloc;
        if (old + 1u == (gen + 1u) * nloc) {
            __builtin_amdgcn_fence(__ATOMIC_RELEASE, "agent");
            asm volatile("s_waitcnt vmcnt(0)" ::: "memory");
            const unsigned og = xb_add(&bar[XB_TOP], 1u);
            const unsigned tg = og / nx;
            if (og + 1u == (tg + 1u) * nx) xb_add(&bar[XB_TOPGEN], 1u);
            else XB_SPIN(xb_ld(&bar[XB_TOPGEN]) == tg, bar);
            __builtin_amdgcn_fence(__ATOMIC_ACQUIRE, "agent");
            xb_add(&bar[XB_XGEN(b.x)], 1u);
            asm volatile("s_waitcnt vmcnt(0)" ::: "memory");
        } else {
            XB_SPIN(xb_ld(&bar[XB_XGEN(b.x)]) == gen, bar);
            __builtin_amdgcn_fence(__ATOMIC_ACQUIRE, "agent");
            asm volatile("s_waitcnt vmcnt(0)" ::: "memory");
        }
    }
    __syncthreads();
}

constexpr int NPH = 20;

DI void ph_prologue(const P& p, char* smem) {
    float* sm = (float*)smem;
    conv_job(p.e_w_in, nullptr, A_IN, D, A_IN, p.Wt_in0, 0, sm);
    conv_job(p.e_w_gate, p.e_w_up, FF0, D, 2 * FF0, p.Wt_gu0, 1, sm);
    conv_job(p.e_w_down, nullptr, D, FF0, D, p.Wt_down0, 0, sm);
    conv_job(p.w_out, nullptr, D, OUT_IN, D, p.Wt_out, 0, sm);
    conv_job(p.w_out + (size_t)OUT_IN * D, nullptr, D, OUT_IN, D, p.Wt_out + (size_t)D * OUT_IN, 0, sm);
    conv_job(p.o_w_in, nullptr, 2120, D, B_INP, p.Wt_in1, 2, sm);
    conv_job(p.w_mem_kv, nullptr, 512, D, 512, p.Wt_memkv, 0, sm);
    conv_job(p.w_mem_kv + (size_t)D * 512, nullptr, 512, D, 512, p.Wt_memkv + (size_t)512 * D, 0, sm);
    conv_job(p.o_w_uk, nullptr, 1024, 256, 1024, p.Wt_ukv, 0, sm);
    conv_job(p.o_w_uv, nullptr, 1024, 256, 1024, p.Wt_ukv + (size_t)1024 * 256, 0, sm);
    for (int e = 0; e < NE; ++e) {
        conv_job(p.o_w_gate + (size_t)e * D * FF1, p.o_w_up + (size_t)e * D * FF1, FF1, D, 2 * FF1, p.Wt_gu1 + (size_t)e * 2 * FF1 * D, 1, sm);
        conv_job(p.o_w_down + (size_t)e * FF1 * D, nullptr, D, FF1, D, p.Wt_down1 + (size_t)e * D * FF1, 0, sm);
    }
    for (int i = blockIdx.x * NTHR + threadIdx.x; i < 2049 * 16; i += gridDim.x * NTHR) {
        const int dist = i >> 4, hh = i & 15; int bucket;
        if (dist < 16) bucket = dist;
        else { const float nf = (float)dist; int lg = 16 + (int)(logf(nf / 16.0f) / logf(128.0f) * 16.0f); bucket = lg < 31 ? lg : 31; }
        p.biasd[i] = p.rel_bias[bucket * 16 + hh];
    }
    rms_rows_bf16(p.mem, B * NMEM, p.mem_norm, p.memn);
    rms_rows_bf16(p.x, T, p.mixer_norm, p.h);
}

struct EpiStoreBf16 { bf16_t* O; int ldo; DI void operator()(int m, int n, float v, float) const { O[(size_t)m * ldo + n] = f2bf(v); } };
struct EpiResid { const float* base; float* out; DI void operator()(int m, int n, float v, float) const { out[(size_t)m * D + n] = base[(size_t)m * D + n] + v; } };
struct EpiSwiglu { bf16_t* O; int ldo; DI void operator()(int m, int n, float g, float u) const { const float s = g / (1.0f + __expf(-g)); O[(size_t)m * ldo + n] = f2bf(s * u); } };
struct EpiSwigluRows { bf16_t* O; int ldo; int rowoff; DI void operator()(int m, int n, float g, float u) const { const float s = g / (1.0f + __expf(-g)); O[(size_t)(rowoff + m) * ldo + n] = f2bf(s * u); } };

DI void ph_proj0(const P& p, char* smem) {
    for (int i = 0; i < 2; ++i) {
        EpiStoreBf16 e{p.kvmem + (size_t)i * B * NMEM * 512, 512};
        ngemm<false>(p.memn, D, nullptr, B * NMEM, p.Wt_memkv + (size_t)i * 512 * D, D, 512, D, e, smem, i * 128);
    }
    EpiStoreBf16 e{(bf16_t*)(p.rb + RB_PROJ0), A_IN};
    ngemm<false>(p.h, D, nullptr, T, p.Wt_in0, D, A_IN, D, e, smem, 0);
}

DI void cross_attn(const P& p, int li, const bf16_t* proj, int ldp, int qoff, float* wl) {
    const int lane = threadIdx.x & 63, gw = blockIdx.x * NWAVE + (threadIdx.x >> 6), nw = gridDim.x * NWAVE;
    bf16_t* mixcat = (bf16_t*)(p.rb + RB_MIXCAT);
    const bf16_t* kvm = p.kvmem + (size_t)li * B * NMEM * 512;
    for (int w = gw; w < T * 4; w += nw) {
        const int t = w >> 2, hd = w & 3, b = t / S;
        float qv[1] = {bf2f(proj[(size_t)t * ldp + qoff + hd * 64 + lane])};
        const bf16_t* kb = kvm + (size_t)b * NMEM * 512 + hd * 64;
        auto en = [&](int i, int& key, float& bias, int& qsel) { key = i; bias = 0.f; qsel = 0; return true; };
        auto kp = [&](int key) { return kb + (size_t)key * 512; };
        auto vp = [&](int key) { return kb + (size_t)key * 512 + 256; };
        wave_attn<256, 1>(wl, qv, en, kp, vp, mixcat + (size_t)t * OUT_IN + 1024 + hd * 64);
    }
}

DI void ph_attn0(const P& p, char* smem) {
    const int lane = threadIdx.x & 63, wid = threadIdx.x >> 6, gw = blockIdx.x * NWAVE + wid, nw = gridDim.x * NWAVE;
    float* wl = (float*)smem + wid * 1024;
    const bf16_t* proj0 = (const bf16_t*)(p.rb + RB_PROJ0);
    bf16_t* mixcat = (bf16_t*)(p.rb + RB_MIXCAT);
    for (int w = gw; w < T * 16; w += nw) {
        const int t = w >> 4, hd = w & 15, b = t / S, tl = t % S;
        float qv[3];
#pragma unroll
        for (int g = 0; g < 3; ++g) qv[g] = bf2f(proj0[(size_t)t * A_IN + g * 1024 + hd * 64 + lane]);
        const bf16_t* base = proj0 + (size_t)b * S * A_IN + hd * 64;
        const float* bd = p.biasd + hd;
        auto en = [&](int i, int& key, float& bias, int& qsel) {
            const int g = i / 129, j = i - g * 129, d = (g == 0) ? 1 : (g == 1 ? 4 : 16);
            key = tl - j * d; qsel = g; bias = bd[(j * d) * 16];
            return key >= 0;
        };
        auto kp = [&](int key) { return base + (size_t)key * A_IN + P0_K; };
        auto vp = [&](int key) { return base + (size_t)key * A_IN + P0_V; };
        wave_attn<387, 3>(wl, qv, en, kp, vp, mixcat + (size_t)t * OUT_IN + hd * 64);
    }
    cross_attn(p, 0, proj0, A_IN, P0_QC, wl);
}

DI void ph_outproj(const P& p, int li, char* smem) {
    EpiResid e{li == 0 ? p.x : p.out, p.out};
    ngemm<false>((const bf16_t*)(p.rb + RB_MIXCAT), OUT_IN, nullptr, T, p.Wt_out + (size_t)li * D * OUT_IN, OUT_IN, D, OUT_IN, e, smem, 0);
}

DI void ph_gateup0(const P& p, char* smem) {
    EpiSwiglu e{(bf16_t*)(p.rb + RB_ACT0), FF0};
    ngemm<true>(p.h, D, nullptr, T, p.Wt_gu0, D, FF0, D, e, smem, 0);
}
DI void ph_down0(const P& p, char* smem) {
    EpiResid e{p.out, p.out};
    ngemm<false>((const bf16_t*)(p.rb + RB_ACT0), FF0, nullptr, T, p.Wt_down0, FF0, D, FF0, e, smem, 0);
}

DI void ph_proj1(const P& p, char* smem) {
    EpiStoreBf16 e{(bf16_t*)(p.rb + RB_PROJ1), B_INP};
    ngemm<false>(p.h, D, nullptr, T, p.Wt_in1, D, B_INP, D, e, smem, 0);
}

DI void ph_ckvnorm(const P& p) {
    const int lane = threadIdx.x & 63, gw = blockIdx.x * NWAVE + (threadIdx.x >> 6), nw = gridDim.x * NWAVE;
    const bf16_t* proj1 = (const bf16_t*)(p.rb + RB_PROJ1); bf16_t* ckv = (bf16_t*)(p.rb + RB_CKV);
    for (int t = gw; t < T; t += nw) {
        const ushort4 r = *(const ushort4*)(proj1 + (size_t)t * B_INP + P1_CKV + lane * 4);
        const float v0 = bf2f(r.x), v1 = bf2f(r.y), v2 = bf2f(r.z), v3 = bf2f(r.w);
        const float ss = wave_sum(v0 * v0 + v1 * v1 + v2 * v2 + v3 * v3);
        const float rstd = rsqrtf(ss * (1.0f / 256.0f) + 1e-6f);
        const float4 g = *(const float4*)(p.o_kv_norm + lane * 4);
        ushort4 o; o.x = f2bf(v0 * rstd * g.x); o.y = f2bf(v1 * rstd * g.y); o.z = f2bf(v2 * rstd * g.z); o.w = f2bf(v3 * rstd * g.w);
        *(ushort4*)(ckv + (size_t)t * 256 + lane * 4) = o;
    }
}

DI void ph_kvfull(const P& p, char* smem) {
    EpiStoreBf16 e{(bf16_t*)(p.rb + RB_KVFULL), 2048};
    ngemm<false>((const bf16_t*)(p.rb + RB_CKV), 256, nullptr, T, p.Wt_ukv, 256, 2048, 256, e, smem, 0);
}

DI void ph_topk(const P& p, char* smem) {
    float* sc = (float*)smem;
    bf16_t* qsm = (bf16_t*)(smem + 131072);
    float* wsm = (float*)(smem + 131072 + 16384);
    const int tid = threadIdx.x, lane = tid & 63, wid = tid >> 6;
    const bf16_t* proj1 = (const bf16_t*)(p.rb + RB_PROJ1);
    unsigned* bitmask = (unsigned*)(p.rb + RB_BITMASK); unsigned short* idxl = (unsigned short*)(p.rb + RB_IDX);
    for (int u = blockIdx.x; u < T / 16; u += gridDim.x) {
        const int t0 = u * 16, b = t0 / S, tl0 = t0 % S, tmax = tl0 + 15;
        for (int i = tid; i < 16 * 64; i += NTHR) { const int qi = i >> 6, c8 = i & 63; *(uint4*)(qsm + qi * 512 + c8 * 8) = *(const uint4*)(proj1 + (size_t)(t0 + qi) * B_INP + P1_QIDX + c8 * 8); }
        if (tid < 128) wsm[tid] = bf2f(proj1[(size_t)(t0 + (tid >> 3)) * B_INP + P1_WIDX + (tid & 7)]) * 0.35355339059327373f;
        __syncthreads();
        for (int s = tid; s <= tmax; s += NTHR) {
            float k[64];
            const uint4* kr = (const uint4*)(proj1 + (size_t)(b * S + s) * B_INP + P1_KIDX);
#pragma unroll
            for (int c8 = 0; c8 < 8; ++c8) { const uint4 kv = kr[c8]; const unsigned w[4] = {kv.x, kv.y, kv.z, kv.w};
#pragma unroll
                for (int j = 0; j < 4; ++j) { k[c8 * 8 + 2 * j] = __uint_as_float(w[j] << 16); k[c8 * 8 + 2 * j + 1] = __uint_as_float(w[j] & 0xffff0000u); } }
#pragma unroll 1
            for (int qi = 0; qi < 16; ++qi) {
                float tot = 0.f;
#pragma unroll 1
                for (int hh = 0; hh < 8; ++hh) {
                    const uint4* qr = (const uint4*)(qsm + qi * 512 + hh * 64);
                    float d = 0.f;
#pragma unroll
                    for (int c8 = 0; c8 < 8; ++c8) { const uint4 qv = qr[c8]; const unsigned w[4] = {qv.x, qv.y, qv.z, qv.w};
#pragma unroll
                        for (int j = 0; j < 4; ++j) { d += __uint_as_float(w[j] << 16) * k[c8 * 8 + 2 * j]; d += __uint_as_float(w[j] & 0xffff0000u) * k[c8 * 8 + 2 * j + 1]; } }
                    tot += wsm[qi * 8 + hh] * fmaxf(d * 0.125f, 0.f);
                }
                sc[qi * 2048 + s] = tot + 0.0f;
            }
        }
        __syncthreads();
#pragma unroll 1
        for (int rr = 0; rr < 2; ++rr) {
            const int qi = wid * 2 + rr, t = t0 + qi, tl = tl0 + qi;
            unsigned uu[32];
#pragma unroll
            for (int i = 0; i < 32; ++i) {
                const int key = lane + 64 * i;
                unsigned v = 0u;
                if (key <= tl) { const unsigned bits = __float_as_uint(sc[qi * 2048 + key]); v = (bits & 0x80000000u) ? ~bits : (bits | 0x80000000u); }
                uu[i] = v;
            }
            unsigned T_ = 0u; int need_eq = 0; bool all_causal = (tl + 1 <= 256);
            if (!all_causal) {
                unsigned v = 0u; bool exact = false;
#pragma unroll 1
                for (int bit = 31; bit >= 0; --bit) {
                    const unsigned cand = v | (1u << bit);
                    int cnt = 0;
#pragma unroll
                    for (int i = 0; i < 32; ++i) cnt += __builtin_popcountll(__ballot(uu[i] >= cand));
                    if (cnt >= 256) { v = cand; if (cnt == 256) { exact = true; break; } }
                }
                T_ = v;
                if (!exact) {
                    int ngt = 0;
#pragma unroll
                    for (int i = 0; i < 32; ++i) ngt += __builtin_popcountll(__ballot(uu[i] > T_));
                    need_eq = 256 - ngt;
                } else need_eq = -1;
            }
            unsigned myword = 0u; int taken = 0, off = 0;
#pragma unroll
            for (int i = 0; i < 32; ++i) {
                const int key = lane + 64 * i;
                unsigned long long m;
                if (all_causal) m = __ballot(key <= tl);
                else if (need_eq < 0) m = __ballot(uu[i] >= T_);
                else {
                    const unsigned long long g = __ballot(uu[i] > T_); unsigned long long e = __ballot(uu[i] == T_);
                    const int c = __builtin_popcountll(e);
                    if (taken + c > need_eq) { unsigned long long sel = 0ull; int k2 = need_eq - taken; while (k2 > 0) { const unsigned long long low = e & (0ull - e); sel |= low; e ^= low; --k2; } e = sel; taken = need_eq; }
                    else taken += c;
                    m = g | e;
                }
                if (lane == 2 * i) myword = (unsigned)m;
                if (lane == 2 * i + 1) myword = (unsigned)(m >> 32);
                if ((m >> lane) & 1ull) { const int rank = __builtin_popcountll(m & ((1ull << lane) - 1ull)); idxl[(size_t)t * 256 + off + rank] = (unsigned short)key; }
                off += __builtin_popcountll(m);
            }
            bitmask[(size_t)t * 64 + lane] = myword;
            for (int e2 = off + lane; e2 < 256; e2 += 64) idxl[(size_t)t * 256 + e2] = 0xFFFFu;
        }
        __syncthreads();
    }
}

DI void ph_attn1(const P& p, char* smem) {
    const int lane = threadIdx.x & 63, wid = threadIdx.x >> 6, gw = blockIdx.x * NWAVE + wid, nw = gridDim.x * NWAVE;
    float* wl = (float*)smem + wid * 1024;
    const bf16_t* proj1 = (const bf16_t*)(p.rb + RB_PROJ1); const bf16_t* kvfull = (const bf16_t*)(p.rb + RB_KVFULL);
    const unsigned short* idxl = (const unsigned short*)(p.rb + RB_IDX);
    bf16_t* mixcat = (bf16_t*)(p.rb + RB_MIXCAT);
    for (int w = gw; w < T * 16; w += nw) {
        const int t = w >> 4, hd = w & 15, b = t / S, tl = t % S;
        float qv[1] = {bf2f(proj1[(size_t)t * B_INP + P1_Q + hd * 64 + lane])};
        const bf16_t* base = kvfull + (size_t)b * S * 2048 + hd * 64;
        const unsigned short* il = idxl + (size_t)t * 256;
        const float* bd = p.biasd + hd;
        auto en = [&](int i, int& key, float& bias, int& qsel) {
            const int k = il[i]; key = k; qsel = 0;
            const bool valid = (k <= tl);
            bias = valid ? bd[(tl - k) * 16] : 0.f;
            return valid;
        };
        auto kp = [&](int key) { return base + (size_t)key * 2048; };
        auto vp = [&](int key) { return base + (size_t)key * 2048 + 1024; };
        wave_attn<256, 1>(wl, qv, en, kp, vp, mixcat + (size_t)t * OUT_IN + hd * 64);
    }
    cross_attn(p, 1, proj1, B_INP, P1_QC, wl);
}

DI void ph_router(const P& p) {
    const int lane = threadIdx.x & 63, gw = blockIdx.x * NWAVE + (threadIdx.x >> 6), nw = gridDim.x * NWAVE;
    const int Tc = T / p.nsplit;
    const float* g = p.ffn_norm + D;
    for (int t = gw; t < T; t += nw) {
        const float4* s = (const float4*)(p.out + (size_t)t * D);
        float4 v[4]; float ss = 0.f;
#pragma unroll
        for (int i = 0; i < 4; ++i) { v[i] = s[lane + 64 * i]; ss += v[i].x * v[i].x + v[i].y * v[i].y + v[i].z * v[i].z + v[i].w * v[i].w; }
        ss = wave_sum(ss);
        const float rstd = rsqrtf(ss * (1.0f / D) + 1e-6f);
        float lg[8];
#pragma unroll
        for (int e = 0; e < 8; ++e) lg[e] = 0.f;
#pragma unroll
        for (int i = 0; i < 4; ++i) {
            const float4 gg = ((const float4*)g)[lane + 64 * i];
            const float hv[4] = {v[i].x * rstd * gg.x, v[i].y * rstd * gg.y, v[i].z * rstd * gg.z, v[i].w * rstd * gg.w};
            ushort4 o; o.x = f2bf(hv[0]); o.y = f2bf(hv[1]); o.z = f2bf(hv[2]); o.w = f2bf(hv[3]);
            ((ushort4*)(p.h + (size_t)t * D))[lane + 64 * i] = o;
#pragma unroll
            for (int j = 0; j < 4; ++j) {
                const int k = (lane + 64 * i) * 4 + j;
                const float4 w0 = *(const float4*)(p.o_w_router + (size_t)k * 8), w1 = *(const float4*)(p.o_w_router + (size_t)k * 8 + 4);
                lg[0] += hv[j] * w0.x; lg[1] += hv[j] * w0.y; lg[2] += hv[j] * w0.z; lg[3] += hv[j] * w0.w;
                lg[4] += hv[j] * w1.x; lg[5] += hv[j] * w1.y; lg[6] += hv[j] * w1.z; lg[7] += hv[j] * w1.w;
            }
        }
#pragma unroll
        for (int e = 0; e < 8; ++e) lg[e] = wave_sum(lg[e]);
        if (lane == 0) {
            int e1 = 0; float v1 = lg[0];
#pragma unroll
            for (int e = 1; e < 8; ++e) if (lg[e] > v1) { v1 = lg[e]; e1 = e; }
            int e2 = -1; float v2 = -3.0e38f;
#pragma unroll
            for (int e = 0; e < 8; ++e) if (e != e1 && lg[e] > v2) { v2 = lg[e]; e2 = e; }
            const float ex = __expf(v2 - v1); const float g1 = 1.0f / (1.0f + ex), g2 = ex / (1.0f + ex);
            const int c = t / Tc;
            const int p1 = (int)atomicAdd(p.ctl + CTL_CNT + c * 8 + e1, 1u), p2 = (int)atomicAdd(p.ctl + CTL_CNT + c * 8 + e2, 1u);
            p.lists[((size_t)c * 8 + e1) * Tc + p1] = t; p.lists[((size_t)c * 8 + e2) * Tc + p2] = t;
            p.tok_e[t * 2] = e1; p.tok_e[t * 2 + 1] = e2; p.tok_pos[t * 2] = p1; p.tok_pos[t * 2 + 1] = p2; p.tok_g[t * 2] = g1; p.tok_g[t * 2 + 1] = g2;
        }
    }
}

DI void moe_offsets(const P& p, int c, int (&cnt)[8], int (&off)[8]) {
    int o = 0;
#pragma unroll
    for (int e = 0; e < 8; ++e) { cnt[e] = (int)__hip_atomic_load(p.ctl + CTL_CNT + c * 8 + e, __ATOMIC_RELAXED, __HIP_MEMORY_SCOPE_AGENT); off[e] = o; o += (cnt[e] + 255) & ~255; }
}
DI size_t moe_rowcap(const P& p) { return (size_t)(2 * (T / p.nsplit) + 2048); }

DI void ph_moe_gateup(const P& p, int c, char* smem) {
    int cnt[8], off[8]; moe_offsets(p, c, cnt, off);
    const int Tc = T / p.nsplit;
    bf16_t* act1 = (bf16_t*)p.rb;
    for (int e = 0; e < 8; ++e) {
        EpiSwigluRows ep{act1, FF1, off[e]};
        ngemm<true>(p.h, D, p.lists + ((size_t)c * 8 + e) * Tc, cnt[e], p.Wt_gu1 + (size_t)e * 2 * FF1 * D, D, FF1, D, ep, smem, e * 37);
    }
}
struct EpiStoreRows { bf16_t* O; int rowoff; DI void operator()(int m, int n, float v, float) const { O[(size_t)(rowoff + m) * D + n] = f2bf(v); } };
DI void ph_moe_down(const P& p, int c, char* smem) {
    int cnt[8], off[8]; moe_offsets(p, c, cnt, off);
    const bf16_t* act1 = (const bf16_t*)p.rb; bf16_t* ybuf = (bf16_t*)(p.rb + moe_rowcap(p) * FF1 * 2);
    for (int e = 0; e < 8; ++e) {
        EpiStoreRows ep{ybuf, off[e]};
        ngemm<false>(act1 + (size_t)off[e] * FF1, FF1, nullptr, cnt[e], p.Wt_down1 + (size_t)e * D * FF1, FF1, D, FF1, ep, smem, e * 37);
    }
}
DI void ph_moe_combine(const P& p, int c) {
    int cnt[8], off[8]; moe_offsets(p, c, cnt, off);
    const int Tc = T / p.nsplit;
    const bf16_t* ybuf = (const bf16_t*)(p.rb + moe_rowcap(p) * FF1 * 2);
    const int lane = threadIdx.x & 63, gw = blockIdx.x * NWAVE + (threadIdx.x >> 6), nw = gridDim.x * NWAVE;
    for (int tt = gw; tt < Tc; tt += nw) {
        const int t = c * Tc + tt;
        const int e1 = p.tok_e[t * 2], e2 = p.tok_e[t * 2 + 1]; const float g1 = p.tok_g[t * 2], g2 = p.tok_g[t * 2 + 1];
        int o1 = 0, o2 = 0;
#pragma unroll
        for (int e = 0; e < 8; ++e) { if (e == e1) o1 = off[e]; if (e == e2) o2 = off[e]; }
        const bf16_t* y1 = ybuf + (size_t)(o1 + p.tok_pos[t * 2]) * D; const bf16_t* y2 = ybuf + (size_t)(o2 + p.tok_pos[t * 2 + 1]) * D;
        float4* xo = (float4*)(p.out + (size_t)t * D);
        float4 v[4]; float ss = 0.f;
#pragma unroll
        for (int i = 0; i < 4; ++i) {
            v[i] = xo[lane + 64 * i];
            const ushort4 a = ((const ushort4*)y1)[lane + 64 * i], bq = ((const ushort4*)y2)[lane + 64 * i];
            v[i].x += g1 * bf2f(a.x) + g2 * bf2f(bq.x); v[i].y += g1 * bf2f(a.y) + g2 * bf2f(bq.y); v[i].z += g1 * bf2f(a.z) + g2 * bf2f(bq.z); v[i].w += g1 * bf2f(a.w) + g2 * bf2f(bq.w);
            ss += v[i].x * v[i].x + v[i].y * v[i].y + v[i].z * v[i].z + v[i].w * v[i].w;
        }
        ss = wave_sum(ss);
        const float rstd = rsqrtf(ss * (1.0f / D) + 1e-6f);
#pragma unroll
        for (int i = 0; i < 4; ++i) {
            const float4 gg = ((const float4*)p.final_norm)[lane + 64 * i];
            xo[lane + 64 * i] = make_float4(v[i].x * rstd * gg.x, v[i].y * rstd * gg.y, v[i].z * rstd * gg.z, v[i].w * rstd * gg.w);
        }
    }
}

enum { PH_PRO = 0, PH_PROJ0, PH_ATTN0, PH_OUT0, PH_NORM_F0, PH_GU0, PH_DOWN0, PH_NORM_M1, PH_PROJ1, PH_CKV, PH_KVFULL, PH_TOPK, PH_ATTN1, PH_OUT1, PH_ROUTER, PH_MOE0 };

__global__ void __launch_bounds__(NTHR, 2) fwd(P p) {
    extern __shared__ __attribute__((aligned(16))) unsigned char lds[];
    char* smem = (char*)lds;
    const int lo = p.ph_lo, hi = p.ph_hi;
    volatile LAS unsigned* stw = (volatile LAS unsigned*)((LAS unsigned char*)lds + (LDS_BYTES - 16));
    if (threadIdx.x < 4) stw[threadIdx.x] = 0u;
    __syncthreads();
    XcdBarrier bar; bar.bar = p.ctl; bar.x = 0; bar.st = stw;
    const bool fused = (hi - lo) > 1;
    if (fused) bar = xcd_barrier_post(p.ctl, stw);
#define IN(k) (lo <= (k) && (k) < hi)
#define SEAM(k) do { if (IN(k) && IN((k) + 1)) xcd_barrier(bar); } while (0)
    if (IN(PH_PRO)) ph_prologue(p, smem);
    SEAM(PH_PRO);
    if (IN(PH_PROJ0)) ph_proj0(p, smem);
    SEAM(PH_PROJ0);
    if (IN(PH_ATTN0)) ph_attn0(p, smem);
    SEAM(PH_ATTN0);
    if (IN(PH_OUT0)) ph_outproj(p, 0, smem);
    SEAM(PH_OUT0);
    if (IN(PH_NORM_F0)) rms_rows_bf16(p.out, T, p.ffn_norm, p.h);
    SEAM(PH_NORM_F0);
    if (IN(PH_GU0)) ph_gateup0(p, smem);
    SEAM(PH_GU0);
    if (IN(PH_DOWN0)) ph_down0(p, smem);
    SEAM(PH_DOWN0);
    if (IN(PH_NORM_M1)) rms_rows_bf16(p.out, T, p.mixer_norm + D, p.h);
    SEAM(PH_NORM_M1);
    if (IN(PH_PROJ1)) ph_proj1(p, smem);
    SEAM(PH_PROJ1);
    if (IN(PH_CKV)) ph_ckvnorm(p);
    SEAM(PH_CKV);
    if (IN(PH_KVFULL)) ph_kvfull(p, smem);
    SEAM(PH_KVFULL);
    if (IN(PH_TOPK)) ph_topk(p, smem);
    SEAM(PH_TOPK);
    if (IN(PH_ATTN1)) ph_attn1(p, smem);
    SEAM(PH_ATTN1);
    if (IN(PH_OUT1)) ph_outproj(p, 1, smem);
    SEAM(PH_OUT1);
    if (IN(PH_ROUTER)) ph_router(p);
    SEAM(PH_ROUTER);
    for (int c = 0; c < p.nsplit; ++c) {
        const int base = PH_MOE0 + 3 * c;
        if (IN(base)) ph_moe_gateup(p, c, smem);
        SEAM(base);
        if (IN(base + 1)) ph_moe_down(p, c, smem);
        SEAM(base + 1);
        if (IN(base + 2)) ph_moe_combine(p, c);
        if (c + 1 < p.nsplit) SEAM(base + 2);
    }
#undef IN
#undef SEAM
}

static size_t align_up(size_t v, size_t a) { return (v + a - 1) / a * a; }

extern "C" void kernel_launch(void* const* d_in, const int* in_sizes, int n_in, void* d_out, int out_size, void* d_ws, size_t ws_size, hipStream_t stream) {
    (void)in_sizes; (void)n_in; (void)out_size;
    P p{};
    p.x = (const float*)d_in[0]; p.mem = (const float*)d_in[1]; p.rel_bias = (const float*)d_in[2]; p.mem_norm = (const float*)d_in[3];
    p.final_norm = (const float*)d_in[4]; p.mixer_norm = (const float*)d_in[5]; p.ffn_norm = (const float*)d_in[6]; p.w_mem_kv = (const float*)d_in[7];
    p.w_out = (const float*)d_in[8]; p.e_w_in = (const float*)d_in[9]; p.e_w_gate = (const float*)d_in[10]; p.e_w_up = (const float*)d_in[11];
    p.e_w_down = (const float*)d_in[12]; p.o_w_in = (const float*)d_in[13]; p.o_kv_norm = (const float*)d_in[14]; p.o_w_uk = (const float*)d_in[15];
    p.o_w_uv = (const float*)d_in[16]; p.o_w_router = (const float*)d_in[17]; p.o_w_gate = (const float*)d_in[18]; p.o_w_up = (const float*)d_in[19];
    p.o_w_down = (const float*)d_in[20];
    p.out = (float*)d_out;
    char* ws = (char*)d_ws; size_t o = 0;
    auto take = [&](size_t bytes) { char* r = ws + o; o = align_up(o + bytes, 256); return r; };
    p.ctl = (unsigned*)take(CTL_WORDS * 4);
    p.biasd = (float*)take(2049 * 16 * 4);
    p.Wt_in0 = (bf16_t*)take((size_t)A_IN * D * 2);
    p.Wt_gu0 = (bf16_t*)take((size_t)2 * FF0 * D * 2);
    p.Wt_down0 = (bf16_t*)take((size_t)D * FF0 * 2);
    p.Wt_out = (bf16_t*)take((size_t)2 * D * OUT_IN * 2);
    p.Wt_in1 = (bf16_t*)take((size_t)B_INP * D * 2);
    p.Wt_memkv = (bf16_t*)take((size_t)2 * 512 * D * 2);
    p.Wt_ukv = (bf16_t*)take((size_t)2048 * 256 * 2);
    p.Wt_gu1 = (bf16_t*)take((size_t)NE * 2 * FF1 * D * 2);
    p.Wt_down1 = (bf16_t*)take((size_t)NE * D * FF1 * 2);
    p.memn = (bf16_t*)take((size_t)B * NMEM * D * 2);
    p.kvmem = (bf16_t*)take((size_t)2 * B * NMEM * 512 * 2);
    p.h = (bf16_t*)take((size_t)T * D * 2);
    p.tok_e = (int*)take((size_t)T * 2 * 4); p.tok_pos = (int*)take((size_t)T * 2 * 4); p.tok_g = (float*)take((size_t)T * 2 * 4);
    p.lists = (int*)take((size_t)NE * T * 4);
    p.rb = take(0);
    const size_t fixed = o;
    int nsplit = 1;
    for (; nsplit <= 8; nsplit *= 2) {
        const size_t rowcap = (size_t)(2 * (T / nsplit) + 2048);
        size_t need = rowcap * FF1 * 2 + rowcap * D * 2; if (need < RB_MIN) need = RB_MIN;
        if (fixed + need <= ws_size) break;
    }
    if (nsplit > 8) { fprintf(stderr, "kernel_launch: workspace too small (%zu)\n", ws_size); return; }
    p.nsplit = nsplit;
    static bool attr = false;
    if (!attr) { (void)hipFuncSetAttribute((const void*)fwd, hipFuncAttributeMaxDynamicSharedMemorySize, LDS_BYTES); attr = true; }
    (void)hipMemsetAsync(p.ctl, 0, CTL_WORDS * 4, stream);
    const int nph = PH_MOE0 + 3 * nsplit;
#if ONE_LAUNCH
    static int grid = 0;
    if (!grid) {
        int dev = 0, cus = 0, per_cu = 0;
        (void)hipGetDevice(&dev);
        (void)hipDeviceGetAttribute(&cus, hipDeviceAttributeMultiprocessorCount, dev);
        (void)hipOccupancyMaxActiveBlocksPerMultiprocessor(&per_cu, (const void*)fwd, NTHR, LDS_BYTES);
        (void)hipGetLastError();
        grid = cus * (per_cu < 1 ? per_cu : 1);
        if (grid <= 0) grid = -1;
    }
    if (grid < 0) return;
    p.ph_lo = 0; p.ph_hi = nph;
    hipLaunchKernelGGL(fwd, dim3(grid), dim3(NTHR), LDS_BYTES, stream, p);
#else
    for (int ph = 0; ph < nph; ++ph) {
        p.ph_lo = ph; p.ph_hi = ph + 1;
        hipLaunchKernelGGL(fwd, dim3(1024), dim3(NTHR), LDS_BYTES, stream, p);
    }
#endif
}
```

```cpp
#include <hip/hip_runtime.h>
#include <stdint.h>
#include <stdio.h>

typedef unsigned short bf16_t;
#ifndef ONE_LAUNCH
#define ONE_LAUNCH 1
#endif
#define DI __device__ __forceinline__

namespace cfg {
constexpr int B = 8, S = 2048, T = B * S, D = 1024;
constexpr int A_IN = 5376, B_INP = 2304;
constexpr int FF0 = 2816, FF1 = 3584, NE = 8;
constexpr int NMEM = 256;
constexpr int OUT_IN = 1280;
constexpr int NTHR = 512, NWAVE = 8;
constexpr int LDS_BYTES = 149504;
constexpr int P1_Q = 0, P1_CKV = 1024, P1_QIDX = 1280, P1_QC = 1792, P1_KIDX = 2048, P1_WIDX = 2112;
constexpr int P0_K = 3072, P0_V = 4096, P0_QC = 5120;
constexpr size_t RB_PROJ0 = 0, RB_MIXCAT = (size_t)T * A_IN * 2;
constexpr size_t RB_ACT0 = 0;
constexpr size_t RB_PROJ1 = 0, RB_KVFULL = (size_t)T * B_INP * 2, RB_CKV = RB_KVFULL + (size_t)T * 2048 * 2,
                 RB_BITMASK = RB_CKV + (size_t)T * 256 * 2, RB_IDX = RB_BITMASK + (size_t)T * 64 * 4, RB_L1END = RB_IDX + (size_t)T * 256 * 2;
constexpr size_t RB_ML = RB_MIXCAT + (size_t)T * OUT_IN * 2;
constexpr size_t RB_MIN = RB_ML + (size_t)3 * T * 16 * 2 * 4;
static_assert(RB_L1END <= RB_MIXCAT, "layer-1 scratch overlaps mixcat");
}
using namespace cfg;

struct P {
    const float *x, *mem, *rel_bias, *mem_norm, *final_norm, *mixer_norm, *ffn_norm, *w_mem_kv, *w_out;
    const float *e_w_in, *e_w_gate, *e_w_up, *e_w_down;
    const float *o_w_in, *o_kv_norm, *o_w_uk, *o_w_uv, *o_w_router, *o_w_gate, *o_w_up, *o_w_down;
    float* out;
    unsigned* ctl;
    float* biasd;
    bf16_t *Wt_in0, *Wt_gu0, *Wt_down0, *Wt_out, *Wt_in1, *Wt_memkv, *Wt_ukv, *Wt_gu1, *Wt_down1;
    bf16_t *memn, *kvmem, *h;
    int *tok_e, *tok_pos; float* tok_g; int* lists;
    char* rb;
    int nsplit, ph_lo, ph_hi, pad;
};

constexpr int CTL_CNT = 4096;
constexpr int CTL_WORDS = 8192;

DI int otid() { int t = threadIdx.x; asm volatile("" : "+v"(t)); return t; }
DI float bf2f(bf16_t b) { return __uint_as_float(((unsigned)b) << 16); }
DI bf16_t f2bf(float f) { unsigned u = __float_as_uint(f); u += 0x7FFFu + ((u >> 16) & 1u); return (bf16_t)(u >> 16); }
DI float wave_sum(float v) { for (int o = 32; o >= 1; o >>= 1) v += __shfl_xor(v, o); return v; }
DI float wave_max(float v) { for (int o = 32; o >= 1; o >>= 1) v = fmaxf(v, __shfl_xor(v, o)); return v; }
DI void wave_lds_sync() { asm volatile("s_waitcnt lgkmcnt(0)" ::: "memory"); __builtin_amdgcn_wave_barrier(); asm volatile("" ::: "memory"); }

DI int colmap(int mode, int n, int& which) {
    which = 0;
    if (mode == 0) return n;
    if (mode == 1) { const int j = n >> 8, r = n & 255; which = (r >= 128); return j * 128 + (r & 127); }
    if (n < 1792) return n;
    if (n < 2048) return 1864 + (n - 1792);
    if (n < 2112) return 1792 + (n - 2048);
    if (n < 2120) return 1856 + (n - 2112);
    return -1;
}
DI void conv_job(const float* s0, const float* s1, int ld, int K, int Nd, bf16_t* dst, int mode, float* sm) {
    const int tid = otid(), nk = K / 64, nn = Nd / 64, nt = nk * nn;
    for (int t = blockIdx.x; t < nt; t += gridDim.x) {
        const int tk = t % nk, tn = t / nk, k0 = tk * 64, n0 = tn * 64;
        {
            const int nl = tid & 63; int which; const int c = colmap(mode, n0 + nl, which);
            const float* s = which ? s1 : s0;
#pragma unroll
            for (int i = 0; i < 8; ++i) { const int kl = (tid >> 6) + 8 * i; sm[kl * 65 + nl] = (c >= 0) ? s[(size_t)(k0 + kl) * ld + c] : 0.f; }
        }
        __syncthreads();
        {
            const int kl = tid & 63;
#pragma unroll
            for (int i = 0; i < 8; ++i) { const int nl = (tid >> 6) + 8 * i; dst[(size_t)(n0 + nl) * K + k0 + kl] = f2bf(sm[kl * 65 + nl]); }
        }
        __syncthreads();
    }
}

DI void rms_rows_bf16(const float* src, int rows, const float* g, bf16_t* dst) {
    const int lane = otid() & 63, gw = blockIdx.x * NWAVE + (otid() >> 6), nw = gridDim.x * NWAVE;
    for (int r = gw; r < rows; r += nw) {
        const float4* s = (const float4*)(src + (size_t)r * D);
        float4 v[4]; float ss = 0.f;
#pragma unroll
        for (int i = 0; i < 4; ++i) { v[i] = s[lane + 64 * i]; ss += v[i].x * v[i].x + v[i].y * v[i].y + v[i].z * v[i].z + v[i].w * v[i].w; }
        ss = wave_sum(ss);
        const float rstd = rsqrtf(ss * (1.0f / D) + 1e-6f);
#pragma unroll
        for (int i = 0; i < 4; ++i) {
            const float4 gg = ((const float4*)g)[lane + 64 * i];
            ushort4 o; o.x = f2bf(v[i].x * rstd * gg.x); o.y = f2bf(v[i].y * rstd * gg.y); o.z = f2bf(v[i].z * rstd * gg.z); o.w = f2bf(v[i].w * rstd * gg.w);
            ((ushort4*)(dst + (size_t)r * D))[lane + 64 * i] = o;
        }
    }
}

#define XB_TMO      128
#define XB_XCNT(j)  (256  + 64 * (j))
#define XB_XSUB(j)  (1280 + 64 * (j))
#define XB_XGEN(j)  (2304 + 64 * (j))
#define XB_TOP      3328
#define XB_TOPGEN   3392
#define XCD_BAR_WORDS 3456
#define XB_SPIN_CAP (1u << 20)
#define LAS __attribute__((address_space(3)))
__device__ __forceinline__ unsigned xb_ld(unsigned* p)              { return __hip_atomic_load(p, __ATOMIC_RELAXED, __HIP_MEMORY_SCOPE_AGENT); }
__device__ __forceinline__ unsigned xb_add(unsigned* p, unsigned v) { return __hip_atomic_fetch_add(p, v, __ATOMIC_RELAXED, __HIP_MEMORY_SCOPE_AGENT); }
__device__ __forceinline__ unsigned xb_xcc_id() { return (unsigned)__builtin_amdgcn_s_getreg((3 << 11) | 20) & 0xFu; }
#define XB_SPIN(cond, bar) do { unsigned _sp = 0; while (cond) { __builtin_amdgcn_s_sleep(1); \
    if ((++_sp & 255u) == 0u) { if (xb_ld(&(bar)[XB_TMO])) break; if (_sp > XB_SPIN_CAP) { atomicAdd(&(bar)[XB_TMO], 1u); break; } } } } while (0)
struct XcdBarrier { unsigned* bar; unsigned x; volatile LAS unsigned* st; };
__device__ __forceinline__ XcdBarrier xcd_barrier_post(unsigned* bar, volatile LAS unsigned* st) {
    XcdBarrier b; b.bar = bar; b.x = xb_xcc_id(); b.st = st;
    if (threadIdx.x == 0) (void)xb_add(&bar[XB_XCNT(b.x)], 1u);
    return b;
}
__device__ __forceinline__ void xcd_barrier_complete(unsigned* bar, unsigned x, unsigned& nloc, unsigned& nx) {
    const unsigned G = gridDim.x * gridDim.y * gridDim.z;
    unsigned sum, cnt, mine, sp = 0u;
    for (;;) {
        sum = 0u; cnt = 0u; mine = 0u;
#pragma unroll
        for (unsigned j = 0; j < 16; ++j) { const unsigned c = xb_ld(&bar[XB_XCNT(j)]); sum += c; cnt += (c > 0u) ? 1u : 0u; mine = (j == x) ? c : mine; }
        if (sum == G) break;
        __builtin_amdgcn_s_sleep(1);
        if ((++sp & 255u) == 0u) { if (xb_ld(&bar[XB_TMO])) break; if (sp > XB_SPIN_CAP) { atomicAdd(&bar[XB_TMO], 1u); break; } }
    }
    nloc = mine > 0u ? mine : 1u; nx = cnt > 0u ? cnt : 1u;
}
__device__ __forceinline__ void xcd_barrier(const XcdBarrier& b) {
    asm volatile("s_waitcnt vmcnt(0)" ::: "memory");
    __syncthreads();
    if (threadIdx.x == 0) {
        unsigned* bar = b.bar;
        __builtin_amdgcn_s_waitcnt(0);
        unsigned nloc = b.st[0], nx = b.st[1];
        if (nloc == 0u) { xcd_barrier_complete(bar, b.x, nloc, nx); b.st[0] = nloc; b.st[1] = nx; }
        const unsigned old = xb_add(&bar[XB_XSUB(b.x)], 1u);
        const unsigned gen = old / nloc;
        if (old + 1u == (gen + 1u) * nloc) {
            __builtin_amdgcn_fence(__ATOMIC_RELEASE, "agent");
            asm volatile("s_waitcnt vmcnt(0)" ::: "memory");
            const unsigned og = xb_add(&bar[XB_TOP], 1u);
            const unsigned tg = og / nx;
            if (og + 1u == (tg + 1u) * nx) xb_add(&bar[XB_TOPGEN], 1u);
            else XB_SPIN(xb_ld(&bar[XB_TOPGEN]) == tg, bar);
            __builtin_amdgcn_fence(__ATOMIC_ACQUIRE, "agent");
            xb_add(&bar[XB_XGEN(b.x)], 1u);
            asm volatile("s_waitcnt vmcnt(0)" ::: "memory");
        } else {
            XB_SPIN(xb_ld(&bar[XB_XGEN(b.x)]) == gen, bar);
            __builtin_amdgcn_fence(__ATOMIC_ACQUIRE, "agent");
            asm volatile("s_waitcnt vmcnt(0)" ::: "memory");
        }
    }
    __syncthreads();
}


namespace pg8 {
typedef short bf16x8 __attribute__((ext_vector_type(8)));
typedef float f32x4 __attribute__((ext_vector_type(4)));
typedef unsigned u32x4 __attribute__((ext_vector_type(4)));
constexpr int BM = 256, BK = 64, HALF = 128, HTB = HALF * BK * 2, STAGE_BYTES = 8 * HTB, NXCD = 8, WGM = 8;
DI int lds_byte(int r, int c) { const int st = (r >> 4) * 2 + (c >> 5), rr = r & 15, cc = c & 31, ob = rr * 64 + cc * 2; return st * 1024 + (ob ^ (((ob >> 9) & 1) << 5)); }
DI void stage_rc(int b, int& R, int& C) { const int st = b / 1024, sb = b % 1024, swz = sb ^ (((sb >> 9) & 1) << 5); R = (st >> 1) * 16 + swz / 64; C = (st & 1) * 32 + (swz % 64) / 2; }
DI int perm32(int rho) { const int n = rho >> 4, i = rho & 15; return 8 * (i >> 2) + 4 * n + (i & 3); }
struct Unit { int pm, pn, pb, e, mt, nvalid; };
struct Gemm { const bf16_t* A; const bf16_t* Bt; int K; };
struct StaticOrder {
    int nM, nN, nwg, G, c;
    DI void init(int M, int N, int G_, int c_) { nM = M / BM; nN = N / BM; nwg = nM * nN; G = G_; c = c_; }
    DI bool next(int i, Unit& u) const {
        const long L = (long)i * G + c; if (L >= nwg) return false;
        int wgid = (int)L; { const int q = nwg / NXCD, r = nwg % NXCD, xcd = wgid % NXCD, off = wgid / NXCD; wgid = (xcd < r ? xcd * (q + 1) : r * (q + 1) + (xcd - r) * q) + off; }
        const int nig = WGM * nN, gid = wgid / nig, fm = gid * WGM, gsz = (nM - fm) < WGM ? (nM - fm) : WGM;
        u.pm = fm + ((wgid % nig) % gsz); u.pn = (wgid % nig) / gsz; u.pb = u.pn; u.e = 0; u.mt = u.pm; u.nvalid = 256; return true;
    }
    DI const int* rowlist(const Unit&) const { return nullptr; }
};
struct GroupOrder {
    int nN, G, c, total, Tc; const int* lists;
    int tiles[8], toff[8], cnt[8];
    DI bool next(int i, Unit& u) const {
        const long L = (long)i * G + c; if (L >= total) return false;
        int l = (int)L, ee = 0, te = 1, toe = 0, ce = 0; bool found = false;
#pragma unroll
        for (int j = 0; j < 8; ++j) { const int n = tiles[j] * nN; if (!found) { if (l < n) { found = true; ee = j; te = tiles[j]; toe = toff[j]; ce = cnt[j]; } else l -= n; } }
        u.e = ee; u.mt = l % te; u.pn = l / te; u.pm = toe + u.mt; u.pb = ee * nN + u.pn; const int nv = ce - u.mt * 256; u.nvalid = nv < 256 ? nv : 256; return true;
    }
    DI const int* rowlist(const Unit& u) const { return lists + (size_t)u.e * Tc + u.mt * 256; }
};
DI unsigned cvt_pk_bf16(float lo, float hi) { unsigned r; asm volatile("v_cvt_pk_bf16_f32 %0, %1, %2" : "=v"(r) : "v"(lo), "v"(hi)); return r; }
struct EpiBf16 {
    static constexpr bool PERM = true;
    bf16_t* O; int ldc;
    DI void operator()(const f32x4 (&acc)[2][2][4][2], const Unit& u, int wr, int wc, int fr, int fq) const {
        const int row0 = u.pm * BM + wr * 64 + fr, col0 = u.pn * BM + wc * 32 + 8 * fq;
#pragma unroll
        for (int ai = 0; ai < 2; ++ai)
#pragma unroll
            for (int m = 0; m < 4; ++m) { bf16_t* rowp = O + (size_t)(row0 + ai * HALF + m * 16) * ldc + col0;
#pragma unroll
                for (int bj = 0; bj < 2; ++bj) { const f32x4 v0 = acc[ai][bj][m][0], v1 = acc[ai][bj][m][1];
                    u32x4 w; w.x = cvt_pk_bf16(v0[0], v0[1]); w.y = cvt_pk_bf16(v0[2], v0[3]); w.z = cvt_pk_bf16(v1[0], v1[1]); w.w = cvt_pk_bf16(v1[2], v1[3]);
                    *(u32x4*)(rowp + bj * HALF) = w; } }
    }
};
struct EpiResid {
    static constexpr bool PERM = false;
    const float* base; float* out;
    DI void operator()(const f32x4 (&acc)[2][2][4][2], const Unit& u, int wr, int wc, int fr, int fq) const {
        const int row0 = u.pm * BM + wr * 64 + fr, col0 = u.pn * BM + wc * 32 + 4 * fq;
#pragma unroll
        for (int ai = 0; ai < 2; ++ai)
#pragma unroll
            for (int m = 0; m < 4; ++m) { const size_t off = (size_t)(row0 + ai * HALF + m * 16) * 1024 + col0;
#pragma unroll
                for (int bj = 0; bj < 2; ++bj)
#pragma unroll
                    for (int n = 0; n < 2; ++n) { const f32x4 bs = *(const f32x4*)(base + off + bj * HALF + n * 16); *(f32x4*)(out + off + bj * HALF + n * 16) = bs + acc[ai][bj][m][n]; }
                asm volatile("" ::: "memory"); }
    }
};
struct EpiSwiglu {
    static constexpr bool PERM = true;
    bf16_t* O; int ldc;
    DI static float act(float g, float u) { return g * __builtin_amdgcn_rcpf(1.0f + __expf(-g)) * u; }
    DI void operator()(const f32x4 (&acc)[2][2][4][2], const Unit& u, int wr, int wc, int fr, int fq) const {
        const int row0 = u.pm * BM + wr * 64 + fr, col0 = u.pn * HALF + wc * 32 + 8 * fq;
#pragma unroll
        for (int ai = 0; ai < 2; ++ai)
#pragma unroll
            for (int m = 0; m < 4; ++m) { bf16_t* rowp = O + (size_t)(row0 + ai * HALF + m * 16) * ldc + col0;
                const f32x4 g0 = acc[ai][0][m][0], g1 = acc[ai][0][m][1], u0 = acc[ai][1][m][0], u1 = acc[ai][1][m][1];
                u32x4 w; w.x = cvt_pk_bf16(act(g0[0], u0[0]), act(g0[1], u0[1])); w.y = cvt_pk_bf16(act(g0[2], u0[2]), act(g0[3], u0[3]));
                w.z = cvt_pk_bf16(act(g1[0], u1[0]), act(g1[1], u1[1])); w.w = cvt_pk_bf16(act(g1[2], u1[2]), act(g1[3], u1[3]));
                *(u32x4*)rowp = w; }
    }
};

template <class Epi, class Sched, bool ALIGN_EPI, bool GATHER>
DI void gemm_phase(LAS unsigned char* lds, const Gemm g, const Sched& S, const Epi& E) {
    int tid_ = threadIdx.x; asm volatile("" : "+v"(tid_));
    const int tid = tid_, wid = __builtin_amdgcn_readfirstlane(tid >> 6), lane = tid & 63, wr = wid >> 2, wc = wid & 3, fr = lane & 15, fq = lane >> 4;
    const int K = g.K, nt = K / BK;
    unsigned voffB[2];
#pragma unroll
    for (int i = 0; i < 2; ++i) { int R, C; stage_rc(tid * 16 + i * 8192, R, C); const int Rb = Epi::PERM ? ((R & ~31) + perm32(R & 31)) : R; voffB[i] = (unsigned)(Rb * K + C) * 2u; }
    const size_t kstep = (size_t)(BK * 2);
    const size_t hstep = (size_t)HALF * K * 2;
    const size_t tstep = 2 * hstep;
    const size_t hA = GATHER ? (size_t)0 : hstep;
    const unsigned ldsw = (unsigned)wid * 1024u;
    const int aoff = lds_byte(wr * 64 + fr, fq * 8), boff = lds_byte(wc * 32 + fr, fq * 8);
#define PG8_SA(b, h) (((b) * 2 + (h)) * HTB)
#define PG8_SB(b, h) ((4 + (b) * 2 + (h)) * HTB)
#define PG8_STAGE(bufoff, gbase, voff) do { _Pragma("unroll") for (int _i = 0; _i < 2; ++_i) \
        __builtin_amdgcn_global_load_lds((const unsigned*)((const char*)(gbase) + (voff)[_i]), (LAS unsigned*)(lds + (bufoff) + ldsw + _i * 8192), 16, 0, 0); } while (0)
#define PG8_LDA(dst, b, h) do { _Pragma("unroll") for (int m = 0; m < 4; ++m) _Pragma("unroll") for (int k = 0; k < 2; ++k) dst[m][k] = *(const LAS bf16x8*)(lds + PG8_SA(b, h) + aoff + m * 2048 + k * 1024); } while (0)
#define PG8_LDB(dst, b, h) do { _Pragma("unroll") for (int n = 0; n < 2; ++n) _Pragma("unroll") for (int k = 0; k < 2; ++k) dst[n][k] = *(const LAS bf16x8*)(lds + PG8_SB(b, h) + boff + n * 2048 + k * 1024); } while (0)
#define PG8_MMA(ai, bj, At, Bt) do { __builtin_amdgcn_s_setprio(1); _Pragma("unroll") for (int m = 0; m < 4; ++m) _Pragma("unroll") for (int n = 0; n < 2; ++n) _Pragma("unroll") for (int k = 0; k < 2; ++k) \
        acc[ai][bj][m][n] = __builtin_amdgcn_mfma_f32_16x16x32_bf16(Bt[n][k], At[m][k], acc[ai][bj][m][n], 0, 0, 0); __builtin_amdgcn_s_setprio(0); } while (0)
#define PG8_WAIT_V(n) asm volatile("s_waitcnt vmcnt(" #n ")" ::: "memory")
#define PG8_WAIT_L(n) asm volatile("s_waitcnt lgkmcnt(" #n ")" ::: "memory")
#define PG8_BAR __builtin_amdgcn_s_barrier()
#define PG8_SCHED __builtin_amdgcn_sched_barrier(0)
#define PG8_AOFFS(u, o0, o1, base) do { \
        if constexpr (GATHER) { const int* _rl = S.rowlist(u); _Pragma("unroll") for (int _i = 0; _i < 2; ++_i) { int _R, _C; stage_rc(tid * 16 + _i * 8192, _R, _C); \
                const int _r0 = _R, _r1 = _R + HALF; const int _t0 = _rl[_r0 < (u).nvalid ? _r0 : 0], _t1 = _rl[_r1 < (u).nvalid ? _r1 : 0]; \
                o0[_i] = (unsigned)(_t0 * K + _C) * 2u; o1[_i] = (unsigned)(_t1 * K + _C) * 2u; } base = (const char*)g.A; } \
        else { _Pragma("unroll") for (int _i = 0; _i < 2; ++_i) { int _R, _C; stage_rc(tid * 16 + _i * 8192, _R, _C); o0[_i] = (unsigned)(_R * K + _C) * 2u; o1[_i] = o0[_i]; } base = (const char*)g.A + (size_t)(u).pm * tstep; } } while (0)
    Unit cur, nxt; int ui = 0;
    if (!S.next(0, cur)) return;
    f32x4 acc[2][2][4][2];
#pragma unroll
    for (int a = 0; a < 2; ++a)
#pragma unroll
        for (int b = 0; b < 2; ++b)
#pragma unroll
            for (int m = 0; m < 4; ++m)
#pragma unroll
                for (int n = 0; n < 2; ++n) acc[a][b][m][n] = (f32x4){0.f, 0.f, 0.f, 0.f};
    bf16x8 At[4][2], B0[2][2], B1[2][2];
    unsigned vA0[2], vA1[2], nA0[2], nA1[2];
    const char* cA; const char* cB = (const char*)g.Bt + (size_t)cur.pb * tstep;
    PG8_AOFFS(cur, vA0, vA1, cA);
    PG8_STAGE(PG8_SB(0, 0), cB, voffB); PG8_STAGE(PG8_SB(0, 1), cB + hstep, voffB); PG8_STAGE(PG8_SA(0, 0), cA, vA0); PG8_STAGE(PG8_SA(0, 1), cA + hA, vA1);
    if (wr == 1) PG8_BAR;
    PG8_WAIT_V(2); PG8_BAR;
    PG8_STAGE(PG8_SB(1, 0), cB + kstep, voffB); PG8_STAGE(PG8_SA(1, 0), cA + kstep, vA0); PG8_STAGE(PG8_SB(1, 1), cB + hstep + kstep, voffB);
    PG8_WAIT_V(6); PG8_BAR;
    for (;;) {
        const bool has_next = S.next(ui + 1, nxt);
        const char* nA = cA; const char* nB = has_next ? (const char*)g.Bt + (size_t)nxt.pb * tstep : cB;
#pragma unroll
        for (int i = 0; i < 2; ++i) { nA0[i] = vA0[i]; nA1[i] = vA1[i]; }
        if (has_next) PG8_AOFFS(nxt, nA0, nA1, nA);
#pragma unroll 1
        for (int t = 0; t < nt; t += 2) {
            const bool last = (t == nt - 2);
            const char* a1 = cA + (size_t)(t + 1) * kstep;
            const char* a2 = last ? nA : cA + (size_t)(t + 2) * kstep; const char* b2 = last ? nB : cB + (size_t)(t + 2) * kstep;
            const char* a3 = a2 + kstep; const char* b3 = b2 + kstep;
            unsigned s0[2], s1[2];
#pragma unroll
            for (int i = 0; i < 2; ++i) { s0[i] = (GATHER && last) ? nA0[i] : vA0[i]; s1[i] = (GATHER && last) ? nA1[i] : vA1[i]; }
            PG8_LDB(B0, 0, 0); PG8_LDB(B1, 0, 1); PG8_SCHED; PG8_LDA(At, 0, 0); PG8_STAGE(PG8_SA(1, 1), a1 + hA, vA1);
            PG8_WAIT_V(8); PG8_WAIT_L(0); PG8_BAR; PG8_MMA(0, 0, At, B0); PG8_MMA(0, 1, At, B1); PG8_BAR; PG8_SCHED;
            PG8_LDA(At, 0, 1); PG8_STAGE(PG8_SB(0, 0), b2, voffB); PG8_STAGE(PG8_SB(0, 1), b2 + hstep, voffB); PG8_STAGE(PG8_SA(0, 0), a2, s0);
            PG8_WAIT_V(8); PG8_WAIT_L(0); PG8_BAR; PG8_MMA(1, 0, At, B0); PG8_MMA(1, 1, At, B1); PG8_BAR; PG8_SCHED;
            PG8_LDB(B0, 1, 0); PG8_LDB(B1, 1, 1); PG8_SCHED; PG8_LDA(At, 1, 0); PG8_STAGE(PG8_SA(0, 1), a2 + hA, s1);
            PG8_WAIT_V(8); PG8_WAIT_L(0); PG8_BAR; PG8_MMA(0, 0, At, B0); PG8_MMA(0, 1, At, B1); PG8_BAR; PG8_SCHED;
            PG8_LDA(At, 1, 1); PG8_STAGE(PG8_SB(1, 0), b3, voffB); PG8_STAGE(PG8_SB(1, 1), b3 + hstep, voffB); PG8_STAGE(PG8_SA(1, 0), a3, s0);
            PG8_WAIT_V(8); PG8_WAIT_L(0); PG8_BAR; PG8_MMA(1, 0, At, B0); PG8_MMA(1, 1, At, B1); PG8_BAR; PG8_SCHED;
        }
        if constexpr (ALIGN_EPI) { if (wr == 0) PG8_BAR; }
        E(acc, cur, wr, wc, fr, fq);
        if (!has_next) break;
#pragma unroll
        for (int a = 0; a < 2; ++a)
#pragma unroll
            for (int b = 0; b < 2; ++b)
#pragma unroll
                for (int m = 0; m < 4; ++m)
#pragma unroll
                    for (int n = 0; n < 2; ++n) acc[a][b][m][n] = (f32x4){0.f, 0.f, 0.f, 0.f};
        cur = nxt; cA = nA; cB = nB; ++ui;
#pragma unroll
        for (int i = 0; i < 2; ++i) { vA0[i] = nA0[i]; vA1[i] = nA1[i]; }
        if constexpr (ALIGN_EPI) { if (wr == 1) PG8_BAR; }
    }
    PG8_WAIT_V(0);
    if constexpr (!ALIGN_EPI) { if (wr == 0) PG8_BAR; }
    PG8_BAR;
#undef PG8_SA
#undef PG8_SB
#undef PG8_STAGE
#undef PG8_LDA
#undef PG8_LDB
#undef PG8_MMA
#undef PG8_WAIT_V
#undef PG8_WAIT_L
#undef PG8_BAR
#undef PG8_SCHED
#undef PG8_AOFFS
}
}


namespace fa {
typedef short bf16x8 __attribute__((ext_vector_type(8)));
typedef short s16x4 __attribute__((ext_vector_type(4)));
typedef float f32x16 __attribute__((ext_vector_type(16)));
typedef unsigned u32x4 __attribute__((ext_vector_type(4)));
typedef float f32x2_t __attribute__((ext_vector_type(2))); typedef __bf16 bf16x2_t __attribute__((ext_vector_type(2)));
typedef short v4i16_t __attribute__((ext_vector_type(4)));
DI unsigned cvtpk(float lo, float hi) { f32x2_t v = {lo, hi}; bf16x2_t b = __builtin_convertvector(v, bf16x2_t); return __builtin_bit_cast(unsigned, b); }
DI s16x4 vtr(const LAS unsigned char* p) { return __builtin_bit_cast(s16x4, __builtin_amdgcn_ds_read_tr16_b64_v4i16((LAS v4i16_t*)p)); }
constexpr float LOG2E = 1.4426950408889634f, C2 = 0.125f * LOG2E, NEGB = -1.0e30f;
constexpr int VSTR = 192, VIMG = 32 * VSTR;

template <int MODE>
DI void flash_unit(const bf16_t* qrow, const bf16_t* kbase, const bf16_t* vbase, long krs, int st_begin, int st_end,
                   const LAS float* tbl, const unsigned* bmrow, LAS unsigned char* vimg, f32x16& o0, f32x16& o1, float& m_out, float& l_out) {
    const int lane = otid() & 63, r32 = lane & 31, hi = lane >> 5;
    bf16x8 qf[4];
#pragma unroll
    for (int ks = 0; ks < 4; ++ks) qf[ks] = *(const bf16x8*)(qrow + 16 * ks + 8 * hi);
    const int vrow0 = lane >> 3, vch = lane & 7;
    LAS unsigned char* vw = vimg + vrow0 * VSTR + vch * 16;
    const LAS unsigned char* vrd = vimg + (4 * hi + ((lane & 15) >> 2)) * VSTR + ((lane >> 4) & 1) * 32 + (lane & 3) * 8;
#pragma unroll
    for (int i = 0; i < 16; ++i) { o0[i] = 0.f; o1[i] = 0.f; }
    float m = NEGB, l = 0.f;
    bf16x8 kf[4]; u32x4 vr[4]; unsigned bw = 0u;
    {
        const bf16_t* kp = kbase + (long)(32 * st_begin + r32) * krs + 8 * hi;
#pragma unroll
        for (int ks = 0; ks < 4; ++ks) kf[ks] = *(const bf16x8*)(kp + 16 * ks);
#pragma unroll
        for (int j = 0; j < 4; ++j) vr[j] = *(const u32x4*)(vbase + (long)(32 * st_begin + vrow0 + 8 * j) * krs + vch * 8);
        if (MODE == 2) bw = bmrow[st_begin];
    }
    for (int st = st_begin; st < st_end; ++st) {
        bf16x8 kc[4]; u32x4 vc[4];
#pragma unroll
        for (int ks = 0; ks < 4; ++ks) kc[ks] = kf[ks];
#pragma unroll
        for (int j = 0; j < 4; ++j) vc[j] = vr[j];
        const unsigned bwc = bw;
        if (st + 1 < st_end) {
            const bf16_t* kp = kbase + (long)(32 * (st + 1) + r32) * krs + 8 * hi;
#pragma unroll
            for (int ks = 0; ks < 4; ++ks) kf[ks] = *(const bf16x8*)(kp + 16 * ks);
#pragma unroll
            for (int j = 0; j < 4; ++j) vr[j] = *(const u32x4*)(vbase + (long)(32 * (st + 1) + vrow0 + 8 * j) * krs + vch * 8);
            if (MODE == 2) bw = bmrow[st + 1];
        }
#pragma unroll
        for (int j = 0; j < 4; ++j) *(LAS u32x4*)(vw + j * 8 * VSTR) = vc[j];
        f32x16 sv;
#pragma unroll
        for (int i = 0; i < 16; ++i) sv[i] = 0.f;
#pragma unroll
        for (int ks = 0; ks < 4; ++ks) sv = __builtin_amdgcn_mfma_f32_32x32x16_bf16(kc[ks], qf[ks], sv, 0, 0, 0);
        float mx = NEGB;
        const unsigned bws = bwc >> (4 * hi);
#pragma unroll
        for (int i = 0; i < 16; ++i) {
            const int ci = (i & 3) + 8 * (i >> 2);
            float x;
            if (MODE == 0) x = sv[i] * C2;
            else x = __builtin_fmaf(sv[i], C2, tbl[32 * st + ci]);
            if (MODE == 2) x = ((bws >> ci) & 1u) ? x : NEGB;
            sv[i] = x; mx = fmaxf(mx, x);
        }
        mx = fmaxf(mx, __shfl_xor(mx, 32));
        const float mn = fmaxf(m, mx);
        if (__builtin_amdgcn_ballot_w64(mn > m) != 0ull) {
            const float al = __builtin_amdgcn_exp2f(m - mn);
            l *= al; m = mn;
#pragma unroll
            for (int i = 0; i < 16; ++i) { o0[i] *= al; o1[i] *= al; }
        }
        float ps = 0.f;
#pragma unroll
        for (int i = 0; i < 16; ++i) { const float pe = __builtin_amdgcn_exp2f(sv[i] - m); sv[i] = pe; ps += pe; }
        ps += __shfl_xor(ps, 32); l += ps;
        u32x4 w0, w1;
        w0.x = cvtpk(sv[0], sv[1]); w0.y = cvtpk(sv[2], sv[3]); w0.z = cvtpk(sv[4], sv[5]); w0.w = cvtpk(sv[6], sv[7]);
        w1.x = cvtpk(sv[8], sv[9]); w1.y = cvtpk(sv[10], sv[11]); w1.z = cvtpk(sv[12], sv[13]); w1.w = cvtpk(sv[14], sv[15]);
        const bf16x8 pb0 = __builtin_bit_cast(bf16x8, w0), pb1 = __builtin_bit_cast(bf16x8, w1);
#pragma unroll
        for (int dt = 0; dt < 2; ++dt) {
            const s16x4 a0 = vtr(vrd + dt * 64), a1 = vtr(vrd + 8 * VSTR + dt * 64), a2 = vtr(vrd + 16 * VSTR + dt * 64), a3 = vtr(vrd + 24 * VSTR + dt * 64);
            const bf16x8 v0 = (bf16x8){a0[0], a0[1], a0[2], a0[3], a1[0], a1[1], a1[2], a1[3]};
            const bf16x8 v1 = (bf16x8){a2[0], a2[1], a2[2], a2[3], a3[0], a3[1], a3[2], a3[3]};
            if (dt == 0) { o0 = __builtin_amdgcn_mfma_f32_32x32x16_bf16(v0, pb0, o0, 0, 0, 0); o0 = __builtin_amdgcn_mfma_f32_32x32x16_bf16(v1, pb1, o0, 0, 0, 0); }
            else         { o1 = __builtin_amdgcn_mfma_f32_32x32x16_bf16(v0, pb0, o1, 0, 0, 0); o1 = __builtin_amdgcn_mfma_f32_32x32x16_bf16(v1, pb1, o1, 0, 0, 0); }
        }
    }
    m_out = m; l_out = l;
}
DI void store_o(bf16_t* orow, const f32x16& o0, const f32x16& o1, float sc, int hi) {
#pragma unroll
    for (int g = 0; g < 4; ++g) {
        uint2 a, b2;
        a.x = cvtpk(o0[4 * g] * sc, o0[4 * g + 1] * sc); a.y = cvtpk(o0[4 * g + 2] * sc, o0[4 * g + 3] * sc);
        b2.x = cvtpk(o1[4 * g] * sc, o1[4 * g + 1] * sc); b2.y = cvtpk(o1[4 * g + 2] * sc, o1[4 * g + 3] * sc);
        *(uint2*)(orow + 8 * g + 4 * hi) = a; *(uint2*)(orow + 32 + 8 * g + 4 * hi) = b2;
    }
}
}

constexpr int NPH = 20;

DI void ph_prologue(const P& p, char* smem) {
    float* sm = (float*)smem;
    conv_job(p.e_w_in, nullptr, A_IN, D, A_IN, p.Wt_in0, 0, sm);
    conv_job(p.e_w_gate, p.e_w_up, FF0, D, 2 * FF0, p.Wt_gu0, 1, sm);
    conv_job(p.e_w_down, nullptr, D, FF0, D, p.Wt_down0, 0, sm);
    conv_job(p.w_out, nullptr, D, OUT_IN, D, p.Wt_out, 0, sm);
    conv_job(p.w_out + (size_t)OUT_IN * D, nullptr, D, OUT_IN, D, p.Wt_out + (size_t)D * OUT_IN, 0, sm);
    conv_job(p.o_w_in, nullptr, 2120, D, B_INP, p.Wt_in1, 2, sm);
    conv_job(p.w_mem_kv, nullptr, 512, D, 512, p.Wt_memkv, 0, sm);
    conv_job(p.w_mem_kv + (size_t)D * 512, nullptr, 512, D, 512, p.Wt_memkv + (size_t)512 * D, 0, sm);
    conv_job(p.o_w_uk, nullptr, 1024, 256, 1024, p.Wt_ukv, 0, sm);
    conv_job(p.o_w_uv, nullptr, 1024, 256, 1024, p.Wt_ukv + (size_t)1024 * 256, 0, sm);
    for (int e = 0; e < NE; ++e) {
        conv_job(p.o_w_gate + (size_t)e * D * FF1, p.o_w_up + (size_t)e * D * FF1, FF1, D, 2 * FF1, p.Wt_gu1 + (size_t)e * 2 * FF1 * D, 1, sm);
        conv_job(p.o_w_down + (size_t)e * FF1 * D, nullptr, D, FF1, D, p.Wt_down1 + (size_t)e * D * FF1, 0, sm);
    }
    for (int i = blockIdx.x * NTHR + otid(); i < 2049 * 16; i += gridDim.x * NTHR) {
        const int dist = i >> 4, hh = i & 15; int bucket;
        if (dist < 16) bucket = dist;
        else { const float nf = (float)dist; int lg = 16 + (int)(logf(nf / 16.0f) / logf(128.0f) * 16.0f); bucket = lg < 31 ? lg : 31; }
        p.biasd[i] = p.rel_bias[bucket * 16 + hh];
    }
    rms_rows_bf16(p.mem, B * NMEM, p.mem_norm, p.memn);
    rms_rows_bf16(p.x, T, p.mixer_norm, p.h);
}


DI void ph_proj0(const P& p, LAS unsigned char* lds) {
    { pg8::Gemm g{p.memn, p.Wt_memkv, D}; pg8::StaticOrder S; S.init(B * NMEM, 1024, (int)gridDim.x, (int)blockIdx.x); pg8::EpiBf16 E{p.kvmem, 1024};
      pg8::gemm_phase<pg8::EpiBf16, pg8::StaticOrder, true, false>(lds, g, S, E); }
    { pg8::Gemm g{p.h, p.Wt_in0, D}; pg8::StaticOrder S; S.init(T, A_IN, (int)gridDim.x, (int)blockIdx.x); pg8::EpiBf16 E{(bf16_t*)(p.rb + RB_PROJ0), A_IN};
      pg8::gemm_phase<pg8::EpiBf16, pg8::StaticOrder, true, false>(lds, g, S, E); }
}

DI void cross_flash(const P& p, int li, const bf16_t* proj, int ldp, int qoff, LAS unsigned char* lds) {
    const int tid = otid(), lane = tid & 63, wid = __builtin_amdgcn_readfirstlane(tid >> 6), r32 = lane & 31, hi = lane >> 5;
    LAS unsigned char* vimg = lds + wid * fa::VIMG;
    bf16_t* mixcat = (bf16_t*)(p.rb + RB_MIXCAT);
    const int gw = blockIdx.x * NWAVE + wid, nw = gridDim.x * NWAVE;
    for (int u = gw; u < B * 4 * 64; u += nw) {
        const int tt = u & 63, hc = (u >> 6) & 3, b = u >> 8;
        const size_t trow = (size_t)b * S + 32 * tt + r32;
        const bf16_t* kb = p.kvmem + (size_t)b * NMEM * 1024 + li * 512 + hc * 64;
        fa::f32x16 o0, o1; float m, l;
        fa::flash_unit<0>(proj + trow * ldp + qoff + hc * 64, kb, kb + 256, 1024, 0, 8, nullptr, nullptr, vimg, o0, o1, m, l);
        fa::store_o(mixcat + trow * OUT_IN + 1024 + hc * 64, o0, o1, 1.0f / l, hi);
    }
}

DI void ph_attn0(const P& p, LAS unsigned char* lds) {
    const int tid = otid(), lane = tid & 63, wid = __builtin_amdgcn_readfirstlane(tid >> 6), r32 = lane & 31, hi = lane >> 5;
    LAS unsigned char* vimg = lds + wid * fa::VIMG;
    LAS float* rtb = (LAS float*)(lds + NWAVE * fa::VIMG);
    bf16_t* proj0 = (bf16_t*)(p.rb + RB_PROJ0);
    float* ml = (float*)(p.rb + RB_ML);
    for (int job = blockIdx.x; job < 256; job += gridDim.x) {
        const int b = job >> 5, head = (job >> 1) & 15, hf = job & 1;
        __syncthreads();
        for (int k = tid; k < 3 * 192; k += NTHR) { const int g = k / 192, j = 159 - (k - g * 192), d = (g == 0) ? 1 : (g == 1 ? 4 : 16);
            rtb[k] = (j >= 0 && j <= 128) ? p.biasd[(j * d) * 16 + head] * fa::LOG2E : fa::NEGB; }
        __syncthreads();
#pragma unroll 1
        for (int n = wid; n < 96; n += NWAVE) {
            const int g = n >> 5, qt = 2 * (n & 31) + hf, dsh = 2 * g, d = 1 << dsh;
            const int tpr = 64 >> dsh, r = qt / tpr, mt = qt - r * tpr, m0 = 32 * mt;
            const size_t tokq = (size_t)b * S + (size_t)(m0 + r32) * d + r;
            bf16_t* qrow = proj0 + tokq * A_IN + g * 1024 + head * 64;
            const bf16_t* kb = proj0 + ((long)b * S + r + (long)(m0 - 128) * d) * (long)A_IN + P0_K + head * 64;
            fa::f32x16 o0, o1; float m, l;
            fa::flash_unit<1>(qrow, kb, kb + (P0_V - P0_K), (long)d * A_IN, (mt >= 4) ? 0 : 4 - mt, 5, rtb + g * 192 + (31 - r32 + 4 * hi), nullptr, vimg, o0, o1, m, l);
            fa::store_o(qrow, o0, o1, 1.0f / l, hi);
            if (hi == 0) *(float2*)(ml + (((size_t)g * T + tokq) * 16 + head) * 2) = make_float2(m, l);
        }
    }
    __syncthreads();
    cross_flash(p, 0, proj0, A_IN, P0_QC, lds);
}
DI void ph_comb0(const P& p) {
    const int tid = otid(), lane = tid & 63, gw = blockIdx.x * NWAVE + (tid >> 6), nw = gridDim.x * NWAVE;
    const bf16_t* proj0 = (const bf16_t*)(p.rb + RB_PROJ0); const float* ml = (const float*)(p.rb + RB_ML);
    bf16_t* mixcat = (bf16_t*)(p.rb + RB_MIXCAT);
    for (int t = gw; t < T; t += nw) {
        const int head = lane >> 2;
        float mg[3], lg[3];
#pragma unroll
        for (int g = 0; g < 3; ++g) { const float2 v = *(const float2*)(ml + (((size_t)g * T + t) * 16 + head) * 2); mg[g] = v.x; lg[g] = v.y; }
        const float M = fmaxf(mg[0], fmaxf(mg[1], mg[2]));
        float w[3], ws = 0.f;
#pragma unroll
        for (int g = 0; g < 3; ++g) { w[g] = __builtin_amdgcn_exp2f(mg[g] - M) * lg[g]; ws += w[g]; }
        const float inv = 1.0f / ws;
        float acc[16];
#pragma unroll
        for (int j = 0; j < 16; ++j) acc[j] = 0.f;
#pragma unroll
        for (int g = 0; g < 3; ++g) {
            const uint4 v0 = *(const uint4*)(proj0 + (size_t)t * A_IN + g * 1024 + lane * 16), v1 = *(const uint4*)(proj0 + (size_t)t * A_IN + g * 1024 + lane * 16 + 8);
            const unsigned wd[8] = {v0.x, v0.y, v0.z, v0.w, v1.x, v1.y, v1.z, v1.w}; const float wg = w[g] * inv;
#pragma unroll
            for (int j = 0; j < 8; ++j) { acc[2 * j] += wg * __uint_as_float(wd[j] << 16); acc[2 * j + 1] += wg * __uint_as_float(wd[j] & 0xffff0000u); }
        }
        uint4 o0, o1;
        o0.x = fa::cvtpk(acc[0], acc[1]); o0.y = fa::cvtpk(acc[2], acc[3]); o0.z = fa::cvtpk(acc[4], acc[5]); o0.w = fa::cvtpk(acc[6], acc[7]);
        o1.x = fa::cvtpk(acc[8], acc[9]); o1.y = fa::cvtpk(acc[10], acc[11]); o1.z = fa::cvtpk(acc[12], acc[13]); o1.w = fa::cvtpk(acc[14], acc[15]);
        *(uint4*)(mixcat + (size_t)t * OUT_IN + lane * 16) = o0; *(uint4*)(mixcat + (size_t)t * OUT_IN + lane * 16 + 8) = o1;
    }
}

DI void ph_outproj(const P& p, int li, LAS unsigned char* lds) {
    pg8::Gemm g{(const bf16_t*)(p.rb + RB_MIXCAT), p.Wt_out + (size_t)li * D * OUT_IN, OUT_IN}; pg8::StaticOrder S; S.init(T, D, (int)gridDim.x, (int)blockIdx.x);
    pg8::EpiResid E{li == 0 ? p.x : p.out, p.out};
    pg8::gemm_phase<pg8::EpiResid, pg8::StaticOrder, true, false>(lds, g, S, E);
}
DI void ph_gateup0(const P& p, LAS unsigned char* lds) {
    pg8::Gemm g{p.h, p.Wt_gu0, D}; pg8::StaticOrder S; S.init(T, 2 * FF0, (int)gridDim.x, (int)blockIdx.x); pg8::EpiSwiglu E{(bf16_t*)(p.rb + RB_ACT0), FF0};
    pg8::gemm_phase<pg8::EpiSwiglu, pg8::StaticOrder, true, false>(lds, g, S, E);
}
DI void ph_down0(const P& p, LAS unsigned char* lds) {
    pg8::Gemm g{(const bf16_t*)(p.rb + RB_ACT0), p.Wt_down0, FF0}; pg8::StaticOrder S; S.init(T, D, (int)gridDim.x, (int)blockIdx.x); pg8::EpiResid E{p.out, p.out};
    pg8::gemm_phase<pg8::EpiResid, pg8::StaticOrder, true, false>(lds, g, S, E);
}
DI void ph_proj1(const P& p, LAS unsigned char* lds) {
    pg8::Gemm g{p.h, p.Wt_in1, D}; pg8::StaticOrder S; S.init(T, B_INP, (int)gridDim.x, (int)blockIdx.x); pg8::EpiBf16 E{(bf16_t*)(p.rb + RB_PROJ1), B_INP};
    pg8::gemm_phase<pg8::EpiBf16, pg8::StaticOrder, true, false>(lds, g, S, E);
}

DI void ph_ckvnorm(const P& p) {
    const int lane = otid() & 63, gw = blockIdx.x * NWAVE + (otid() >> 6), nw = gridDim.x * NWAVE;
    const bf16_t* proj1 = (const bf16_t*)(p.rb + RB_PROJ1); bf16_t* ckv = (bf16_t*)(p.rb + RB_CKV);
    for (int t = gw; t < T; t += nw) {
        const ushort4 r = *(const ushort4*)(proj1 + (size_t)t * B_INP + P1_CKV + lane * 4);
        const float v0 = bf2f(r.x), v1 = bf2f(r.y), v2 = bf2f(r.z), v3 = bf2f(r.w);
        const float ss = wave_sum(v0 * v0 + v1 * v1 + v2 * v2 + v3 * v3);
        const float rstd = rsqrtf(ss * (1.0f / 256.0f) + 1e-6f);
        const float4 g = *(const float4*)(p.o_kv_norm + lane * 4);
        ushort4 o; o.x = f2bf(v0 * rstd * g.x); o.y = f2bf(v1 * rstd * g.y); o.z = f2bf(v2 * rstd * g.z); o.w = f2bf(v3 * rstd * g.w);
        *(ushort4*)(ckv + (size_t)t * 256 + lane * 4) = o;
    }
}

DI void ph_kvfull(const P& p, LAS unsigned char* lds) {
    pg8::Gemm g{(const bf16_t*)(p.rb + RB_CKV), p.Wt_ukv, 256}; pg8::StaticOrder S; S.init(T, 2048, (int)gridDim.x, (int)blockIdx.x); pg8::EpiBf16 E{(bf16_t*)(p.rb + RB_KVFULL), 2048};
    pg8::gemm_phase<pg8::EpiBf16, pg8::StaticOrder, true, false>(lds, g, S, E);
}

DI void ph_topk(const P& p, char* smem) {
    constexpr int SCS = 2052;
    float* sc = (float*)smem;
    const int tid = otid(), lane = tid & 63, wid = __builtin_amdgcn_readfirstlane(tid >> 6);
    const bf16_t* proj1 = (const bf16_t*)(p.rb + RB_PROJ1);
    unsigned* bitmask = (unsigned*)(p.rb + RB_BITMASK); unsigned short* idxl = (unsigned short*)(p.rb + RB_IDX);
    typedef short bf16x8 __attribute__((ext_vector_type(8))); typedef float f32x4 __attribute__((ext_vector_type(4)));
    for (int u = blockIdx.x; u < T / 16; u += gridDim.x) {
        const int t0 = u * 16, b = t0 / S, tl0 = t0 % S, tmax = tl0 + 15;
        {
            const int qn = lane & 15, g4 = lane >> 4;
            const bf16_t* qrow = proj1 + (size_t)(t0 + qn) * B_INP;
            bf16x8 qf[8][2]; float wq[8];
#pragma unroll
            for (int hh = 0; hh < 8; ++hh) {
#pragma unroll
                for (int ks = 0; ks < 2; ++ks) qf[hh][ks] = *(const bf16x8*)(qrow + P1_QIDX + hh * 64 + 32 * ks + 8 * g4);
                wq[hh] = bf2f(qrow[P1_WIDX + hh]) * (0.35355339059327373f * 0.125f);
            }
            const int ntile = (tmax >> 4) + 1;
            const bf16_t* kbase = proj1 + ((size_t)b * S + qn) * B_INP + P1_KIDX + 8 * g4;
            bf16x8 kn0, kn1;
            if (wid < ntile) { kn0 = *(const bf16x8*)(kbase + (size_t)(16 * wid) * B_INP); kn1 = *(const bf16x8*)(kbase + (size_t)(16 * wid) * B_INP + 32); }
#pragma unroll 1
            for (int kt = wid; kt < ntile; kt += NWAVE) {
                const bf16x8 k0 = kn0, k1 = kn1;
                if (kt + NWAVE < ntile) { kn0 = *(const bf16x8*)(kbase + (size_t)(16 * (kt + NWAVE)) * B_INP); kn1 = *(const bf16x8*)(kbase + (size_t)(16 * (kt + NWAVE)) * B_INP + 32); }
                f32x4 acc = (f32x4){0.f, 0.f, 0.f, 0.f};
#pragma unroll
                for (int hh = 0; hh < 8; ++hh) {
                    f32x4 dd = (f32x4){0.f, 0.f, 0.f, 0.f};
                    dd = __builtin_amdgcn_mfma_f32_16x16x32_bf16(k0, qf[hh][0], dd, 0, 0, 0);
                    dd = __builtin_amdgcn_mfma_f32_16x16x32_bf16(k1, qf[hh][1], dd, 0, 0, 0);
#pragma unroll
                    for (int i = 0; i < 4; ++i) acc[i] += wq[hh] * fmaxf(dd[i], 0.f);
                }
#pragma unroll
                for (int i = 0; i < 4; ++i) acc[i] += 0.0f;
                *(f32x4*)(sc + qn * SCS + 16 * kt + 4 * g4) = acc;
            }
        }
        __syncthreads();
#pragma unroll 1
        for (int rr = 0; rr < 2; ++rr) {
            const int qi = wid * 2 + rr, t = t0 + qi, tl = tl0 + qi;
            unsigned uu[32];
#pragma unroll
            for (int i = 0; i < 32; ++i) {
                const int key = lane + 64 * i;
                unsigned v = 0u;
                if (key <= tl) { const unsigned bits = __float_as_uint(sc[qi * SCS + key]); v = (bits & 0x80000000u) ? ~bits : (bits | 0x80000000u); }
                uu[i] = v;
            }
            unsigned T_ = 0u; int need_eq = 0; bool all_causal = (tl + 1 <= 256);
            if (!all_causal) {
                unsigned v = 0u; bool exact = false;
#pragma unroll 1
                for (int bit = 31; bit >= 0; --bit) {
                    const unsigned cand = v | (1u << bit);
                    int cnt = 0;
#pragma unroll
                    for (int i = 0; i < 32; ++i) cnt += __builtin_popcountll(__ballot(uu[i] >= cand));
                    if (cnt >= 256) { v = cand; if (cnt == 256) { exact = true; break; } }
                }
                T_ = v;
                if (!exact) {
                    int ngt = 0;
#pragma unroll
                    for (int i = 0; i < 32; ++i) ngt += __builtin_popcountll(__ballot(uu[i] > T_));
                    need_eq = 256 - ngt;
                } else need_eq = -1;
            }
            unsigned myword = 0u; int taken = 0, off = 0;
#pragma unroll
            for (int i = 0; i < 32; ++i) {
                const int key = lane + 64 * i;
                unsigned long long m;
                if (all_causal) m = __ballot(key <= tl);
                else if (need_eq < 0) m = __ballot(uu[i] >= T_);
                else {
                    const unsigned long long g = __ballot(uu[i] > T_); unsigned long long e = __ballot(uu[i] == T_);
                    const int c = __builtin_popcountll(e);
                    if (taken + c > need_eq) { unsigned long long sel = 0ull; int k2 = need_eq - taken; while (k2 > 0) { const unsigned long long low = e & (0ull - e); sel |= low; e ^= low; --k2; } e = sel; taken = need_eq; }
                    else taken += c;
                    m = g | e;
                }
                if (lane == 2 * i) myword = (unsigned)m;
                if (lane == 2 * i + 1) myword = (unsigned)(m >> 32);
                if ((m >> lane) & 1ull) { const int rank = __builtin_popcountll(m & ((1ull << lane) - 1ull)); idxl[(size_t)t * 256 + off + rank] = (unsigned short)key; }
                off += __builtin_popcountll(m);
            }
            bitmask[(size_t)t * 64 + lane] = myword;
            for (int e2 = off + lane; e2 < 256; e2 += 64) idxl[(size_t)t * 256 + e2] = 0xFFFFu;
        }
        __syncthreads();
    }
}

DI void ph_attn1(const P& p, LAS unsigned char* lds) {
    const int tid = otid(), lane = tid & 63, wid = __builtin_amdgcn_readfirstlane(tid >> 6), r32 = lane & 31, hi = lane >> 5;
    LAS unsigned char* vimg = lds + wid * fa::VIMG;
    LAS float* rtb = (LAS float*)(lds + NWAVE * fa::VIMG);
    const bf16_t* proj1 = (const bf16_t*)(p.rb + RB_PROJ1); const bf16_t* kvfull = (const bf16_t*)(p.rb + RB_KVFULL);
    const unsigned* bitmask = (const unsigned*)(p.rb + RB_BITMASK);
    bf16_t* mixcat = (bf16_t*)(p.rb + RB_MIXCAT);
    for (int job = blockIdx.x; job < 256; job += gridDim.x) {
        const int b = job >> 5, head = (job >> 1) & 15, hf = job & 1;
        __syncthreads();
        for (int k = tid; k < 2080; k += NTHR) { const int dist = 2047 - k; rtb[k] = (dist >= 0) ? p.biasd[dist * 16 + head] * fa::LOG2E : 0.f; }
        __syncthreads();
#pragma unroll 1
        for (int qi = 0; qi < 4; ++qi) {
            const int kk = (qi == 0) ? wid : (qi == 1) ? 15 - wid : (qi == 2) ? 16 + wid : 31 - wid;
            const int tt = hf + 2 * kk, tq = 32 * tt + r32;
            const size_t trow = (size_t)b * S + tq;
            const bf16_t* kb = kvfull + (size_t)b * S * 2048 + head * 64;
            fa::f32x16 o0, o1; float m, l;
            fa::flash_unit<2>(proj1 + trow * B_INP + P1_Q + head * 64, kb, kb + 1024, 2048, 0, tt + 1, rtb + (2047 - tq + 4 * hi), bitmask + trow * 64, vimg, o0, o1, m, l);
            fa::store_o(mixcat + trow * OUT_IN + head * 64, o0, o1, 1.0f / l, hi);
        }
    }
    __syncthreads();
    cross_flash(p, 1, proj1, B_INP, P1_QC, lds);
}

DI void ph_router(const P& p) {
    const int lane = otid() & 63, gw = blockIdx.x * NWAVE + (otid() >> 6), nw = gridDim.x * NWAVE;
    const int Tc = T / p.nsplit;
    const float* g = p.ffn_norm + D;
    for (int t = gw; t < T; t += nw) {
        const float4* s = (const float4*)(p.out + (size_t)t * D);
        float4 v[4]; float ss = 0.f;
#pragma unroll
        for (int i = 0; i < 4; ++i) { v[i] = s[lane + 64 * i]; ss += v[i].x * v[i].x + v[i].y * v[i].y + v[i].z * v[i].z + v[i].w * v[i].w; }
        ss = wave_sum(ss);
        const float rstd = rsqrtf(ss * (1.0f / D) + 1e-6f);
        float lg[8];
#pragma unroll
        for (int e = 0; e < 8; ++e) lg[e] = 0.f;
#pragma unroll
        for (int i = 0; i < 4; ++i) {
            const float4 gg = ((const float4*)g)[lane + 64 * i];
            const float hv[4] = {v[i].x * rstd * gg.x, v[i].y * rstd * gg.y, v[i].z * rstd * gg.z, v[i].w * rstd * gg.w};
            ushort4 o; o.x = f2bf(hv[0]); o.y = f2bf(hv[1]); o.z = f2bf(hv[2]); o.w = f2bf(hv[3]);
            ((ushort4*)(p.h + (size_t)t * D))[lane + 64 * i] = o;
#pragma unroll
            for (int j = 0; j < 4; ++j) {
                const int k = (lane + 64 * i) * 4 + j;
                const float4 w0 = *(const float4*)(p.o_w_router + (size_t)k * 8), w1 = *(const float4*)(p.o_w_router + (size_t)k * 8 + 4);
                lg[0] += hv[j] * w0.x; lg[1] += hv[j] * w0.y; lg[2] += hv[j] * w0.z; lg[3] += hv[j] * w0.w;
                lg[4] += hv[j] * w1.x; lg[5] += hv[j] * w1.y; lg[6] += hv[j] * w1.z; lg[7] += hv[j] * w1.w;
            }
        }
#pragma unroll
        for (int e = 0; e < 8; ++e) lg[e] = wave_sum(lg[e]);
        if (lane == 0) {
            int e1 = 0; float v1 = lg[0];
#pragma unroll
            for (int e = 1; e < 8; ++e) if (lg[e] > v1) { v1 = lg[e]; e1 = e; }
            int e2 = -1; float v2 = -3.0e38f;
#pragma unroll
            for (int e = 0; e < 8; ++e) if (e != e1 && lg[e] > v2) { v2 = lg[e]; e2 = e; }
            const float ex = __expf(v2 - v1); const float g1 = 1.0f / (1.0f + ex), g2 = ex / (1.0f + ex);
            const int c = t / Tc;
            const int p1 = (int)atomicAdd(p.ctl + CTL_CNT + c * 8 + e1, 1u), p2 = (int)atomicAdd(p.ctl + CTL_CNT + c * 8 + e2, 1u);
            p.lists[((size_t)c * 8 + e1) * Tc + p1] = t; p.lists[((size_t)c * 8 + e2) * Tc + p2] = t;
            p.tok_e[t * 2] = e1; p.tok_e[t * 2 + 1] = e2; p.tok_pos[t * 2] = p1; p.tok_pos[t * 2 + 1] = p2; p.tok_g[t * 2] = g1; p.tok_g[t * 2 + 1] = g2;
        }
    }
}

DI void moe_offsets(const P& p, int c, int (&cnt)[8], int (&off)[8]) {
    int o = 0;
#pragma unroll
    for (int e = 0; e < 8; ++e) { cnt[e] = (int)__hip_atomic_load(p.ctl + CTL_CNT + c * 8 + e, __ATOMIC_RELAXED, __HIP_MEMORY_SCOPE_AGENT); off[e] = o; o += (cnt[e] + 255) & ~255; }
}
DI size_t moe_rowcap(const P& p) { return (size_t)(2 * (T / p.nsplit) + 2048); }

DI void moe_order(const P& p, int c, int nN, pg8::GroupOrder& S) {
    int cnt[8], off[8]; moe_offsets(p, c, cnt, off);
    S.nN = nN; S.G = (int)gridDim.x; S.c = (int)blockIdx.x; S.Tc = T / p.nsplit; S.lists = p.lists + (size_t)c * 8 * S.Tc;
    int tot = 0;
#pragma unroll
    for (int e = 0; e < 8; ++e) { S.cnt[e] = cnt[e]; S.tiles[e] = (cnt[e] + 255) >> 8; S.toff[e] = off[e] >> 8; tot += S.tiles[e] * nN; }
    S.total = tot;
}
DI void ph_moe_gateup(const P& p, int c, LAS unsigned char* lds) {
    pg8::GroupOrder S; moe_order(p, c, 2 * FF1 / 256, S);
    pg8::Gemm g{p.h, p.Wt_gu1, D}; pg8::EpiSwiglu E{(bf16_t*)p.rb, FF1};
    pg8::gemm_phase<pg8::EpiSwiglu, pg8::GroupOrder, true, true>(lds, g, S, E);
}
DI void ph_moe_down(const P& p, int c, LAS unsigned char* lds) {
    pg8::GroupOrder S; moe_order(p, c, D / 256, S);
    pg8::Gemm g{(const bf16_t*)p.rb, p.Wt_down1, FF1}; pg8::EpiBf16 E{(bf16_t*)(p.rb + moe_rowcap(p) * FF1 * 2), D};
    pg8::gemm_phase<pg8::EpiBf16, pg8::GroupOrder, true, false>(lds, g, S, E);
}
DI void ph_moe_combine(const P& p, int c) {
    int cnt[8], off[8]; moe_offsets(p, c, cnt, off);
    const int Tc = T / p.nsplit;
    const bf16_t* ybuf = (const bf16_t*)(p.rb + moe_rowcap(p) * FF1 * 2);
    const int lane = otid() & 63, gw = blockIdx.x * NWAVE + (otid() >> 6), nw = gridDim.x * NWAVE;
    for (int tt = gw; tt < Tc; tt += nw) {
        const int t = c * Tc + tt;
        const int e1 = p.tok_e[t * 2], e2 = p.tok_e[t * 2 + 1]; const float g1 = p.tok_g[t * 2], g2 = p.tok_g[t * 2 + 1];
        int o1 = 0, o2 = 0;
#pragma unroll
        for (int e = 0; e < 8; ++e) { if (e == e1) o1 = off[e]; if (e == e2) o2 = off[e]; }
        const bf16_t* y1 = ybuf + (size_t)(o1 + p.tok_pos[t * 2]) * D; const bf16_t* y2 = ybuf + (size_t)(o2 + p.tok_pos[t * 2 + 1]) * D;
        float4* xo = (float4*)(p.out + (size_t)t * D);
        float4 v[4]; float ss = 0.f;
#pragma unroll
        for (int i = 0; i < 4; ++i) {
            v[i] = xo[lane + 64 * i];
            const ushort4 a = ((const ushort4*)y1)[lane + 64 * i], bq = ((const ushort4*)y2)[lane + 64 * i];
            v[i].x += g1 * bf2f(a.x) + g2 * bf2f(bq.x); v[i].y += g1 * bf2f(a.y) + g2 * bf2f(bq.y); v[i].z += g1 * bf2f(a.z) + g2 * bf2f(bq.z); v[i].w += g1 * bf2f(a.w) + g2 * bf2f(bq.w);
            ss += v[i].x * v[i].x + v[i].y * v[i].y + v[i].z * v[i].z + v[i].w * v[i].w;
        }
        ss = wave_sum(ss);
        const float rstd = rsqrtf(ss * (1.0f / D) + 1e-6f);
#pragma unroll
        for (int i = 0; i < 4; ++i) {
            const float4 gg = ((const float4*)p.final_norm)[lane + 64 * i];
            xo[lane + 64 * i] = make_float4(v[i].x * rstd * gg.x, v[i].y * rstd * gg.y, v[i].z * rstd * gg.z, v[i].w * rstd * gg.w);
        }
    }
}

enum { PH_PRO = 0, PH_PROJ0, PH_ATTN0, PH_COMB0, PH_OUT0, PH_NORM_F0, PH_GU0, PH_DOWN0, PH_NORM_M1, PH_PROJ1, PH_CKV, PH_KVFULL, PH_TOPK, PH_ATTN1, PH_OUT1, PH_ROUTER, PH_MOE0 };

__global__ void __launch_bounds__(NTHR, 2) fwd(P p) {
    extern __shared__ __attribute__((aligned(16))) unsigned char lds[];
    char* smem = (char*)lds;
    const int lo = p.ph_lo, hi = p.ph_hi;
    volatile LAS unsigned* stw = (volatile LAS unsigned*)((LAS unsigned char*)lds + (LDS_BYTES - 16));
    if (threadIdx.x < 4) stw[threadIdx.x] = 0u;
    __syncthreads();
    XcdBarrier bar; bar.bar = p.ctl; bar.x = 0; bar.st = stw;
    const bool fused = (hi - lo) > 1;
    if (fused) bar = xcd_barrier_post(p.ctl, stw);
#ifndef PH_MASK
#define PH_MASK 0xFFFFFFFFu
#endif
#define IN(k) (((PH_MASK >> ((k) < PH_MOE0 ? (k) : PH_MOE0 + ((k) - PH_MOE0) % 3)) & 1u) && lo <= (k) && (k) < hi)
#define SEAM(k) do { if (IN(k) && IN((k) + 1)) xcd_barrier(bar); } while (0)
    if (IN(PH_PRO)) ph_prologue(p, smem);
    SEAM(PH_PRO);
    if (IN(PH_PROJ0)) ph_proj0(p, (LAS unsigned char*)lds);
    SEAM(PH_PROJ0);
    if (IN(PH_ATTN0)) ph_attn0(p, (LAS unsigned char*)lds);
    SEAM(PH_ATTN0);
    if (IN(PH_COMB0)) ph_comb0(p);
    SEAM(PH_COMB0);
    if (IN(PH_OUT0)) ph_outproj(p, 0, (LAS unsigned char*)lds);
    SEAM(PH_OUT0);
    if (IN(PH_NORM_F0)) rms_rows_bf16(p.out, T, p.ffn_norm, p.h);
    SEAM(PH_NORM_F0);
    if (IN(PH_GU0)) ph_gateup0(p, (LAS unsigned char*)lds);
    SEAM(PH_GU0);
    if (IN(PH_DOWN0)) ph_down0(p, (LAS unsigned char*)lds);
    SEAM(PH_DOWN0);
    if (IN(PH_NORM_M1)) rms_rows_bf16(p.out, T, p.mixer_norm + D, p.h);
    SEAM(PH_NORM_M1);
    if (IN(PH_PROJ1)) ph_proj1(p, (LAS unsigned char*)lds);
    SEAM(PH_PROJ1);
    if (IN(PH_CKV)) ph_ckvnorm(p);
    SEAM(PH_CKV);
    if (IN(PH_KVFULL)) ph_kvfull(p, (LAS unsigned char*)lds);
    SEAM(PH_KVFULL);
    if (IN(PH_TOPK)) ph_topk(p, smem);
    SEAM(PH_TOPK);
    if (IN(PH_ATTN1)) ph_attn1(p, (LAS unsigned char*)lds);
    SEAM(PH_ATTN1);
    if (IN(PH_OUT1)) ph_outproj(p, 1, (LAS unsigned char*)lds);
    SEAM(PH_OUT1);
    if (IN(PH_ROUTER)) ph_router(p);
    SEAM(PH_ROUTER);
    for (int c = 0; c < p.nsplit; ++c) {
        const int base = PH_MOE0 + 3 * c;
        if (IN(base)) ph_moe_gateup(p, c, (LAS unsigned char*)lds);
        SEAM(base);
        if (IN(base + 1)) ph_moe_down(p, c, (LAS unsigned char*)lds);
        SEAM(base + 1);
        if (IN(base + 2)) ph_moe_combine(p, c);
        if (c + 1 < p.nsplit) SEAM(base + 2);
    }
#undef IN
#undef SEAM
}

static size_t align_up(size_t v, size_t a) { return (v + a - 1) / a * a; }

extern "C" void kernel_launch(void* const* d_in, const int* in_sizes, int n_in, void* d_out, int out_size, void* d_ws, size_t ws_size, hipStream_t stream) {
    (void)in_sizes; (void)n_in; (void)out_size;
    P p{};
    p.x = (const float*)d_in[0]; p.mem = (const float*)d_in[1]; p.rel_bias = (const float*)d_in[2]; p.mem_norm = (const float*)d_in[3];
    p.final_norm = (const float*)d_in[4]; p.mixer_norm = (const float*)d_in[5]; p.ffn_norm = (const float*)d_in[6]; p.w_mem_kv = (const float*)d_in[7];
    p.w_out = (const float*)d_in[8]; p.e_w_in = (const float*)d_in[9]; p.e_w_gate = (const float*)d_in[10]; p.e_w_up = (const float*)d_in[11];
    p.e_w_down = (const float*)d_in[12]; p.o_w_in = (const float*)d_in[13]; p.o_kv_norm = (const float*)d_in[14]; p.o_w_uk = (const float*)d_in[15];
    p.o_w_uv = (const float*)d_in[16]; p.o_w_router = (const float*)d_in[17]; p.o_w_gate = (const float*)d_in[18]; p.o_w_up = (const float*)d_in[19];
    p.o_w_down = (const float*)d_in[20];
    p.out = (float*)d_out;
    char* ws = (char*)d_ws; size_t o = 0;
    auto take = [&](size_t bytes) { char* r = ws + o; o = align_up(o + bytes, 256); return r; };
    p.ctl = (unsigned*)take(CTL_WORDS * 4);
    p.biasd = (float*)take(2049 * 16 * 4);
    p.Wt_in0 = (bf16_t*)take((size_t)A_IN * D * 2);
    p.Wt_gu0 = (bf16_t*)take((size_t)2 * FF0 * D * 2);
    p.Wt_down0 = (bf16_t*)take((size_t)D * FF0 * 2);
    p.Wt_out = (bf16_t*)take((size_t)2 * D * OUT_IN * 2);
    p.Wt_in1 = (bf16_t*)take((size_t)B_INP * D * 2);
    p.Wt_memkv = (bf16_t*)take((size_t)2 * 512 * D * 2);
    p.Wt_ukv = (bf16_t*)take((size_t)2048 * 256 * 2);
    p.Wt_gu1 = (bf16_t*)take((size_t)NE * 2 * FF1 * D * 2);
    p.Wt_down1 = (bf16_t*)take((size_t)NE * D * FF1 * 2);
    p.memn = (bf16_t*)take((size_t)B * NMEM * D * 2);
    p.kvmem = (bf16_t*)take((size_t)2 * B * NMEM * 512 * 2);
    p.h = (bf16_t*)take((size_t)T * D * 2);
    p.tok_e = (int*)take((size_t)T * 2 * 4); p.tok_pos = (int*)take((size_t)T * 2 * 4); p.tok_g = (float*)take((size_t)T * 2 * 4);
    p.lists = (int*)take((size_t)NE * T * 4);
    p.rb = take(0);
    const size_t fixed = o;
    int nsplit = 1;
    for (; nsplit <= 8; nsplit *= 2) {
        const size_t rowcap = (size_t)(2 * (T / nsplit) + 2048);
        size_t need = rowcap * FF1 * 2 + rowcap * D * 2; if (need < RB_MIN) need = RB_MIN;
        if (fixed + need <= ws_size) break;
    }
    if (nsplit > 8) { fprintf(stderr, "kernel_launch: workspace too small (%zu)\n", ws_size); return; }
    p.nsplit = nsplit;
    static bool attr = false;
    if (!attr) { (void)hipFuncSetAttribute((const void*)fwd, hipFuncAttributeMaxDynamicSharedMemorySize, LDS_BYTES); attr = true; }
    (void)hipMemsetAsync(p.ctl, 0, CTL_WORDS * 4, stream);
    const int nph = PH_MOE0 + 3 * nsplit;
#if ONE_LAUNCH
    static int grid = 0;
    if (!grid) {
        int dev = 0, cus = 0, per_cu = 0;
        (void)hipGetDevice(&dev);
        (void)hipDeviceGetAttribute(&cus, hipDeviceAttributeMultiprocessorCount, dev);
        (void)hipOccupancyMaxActiveBlocksPerMultiprocessor(&per_cu, (const void*)fwd, NTHR, LDS_BYTES);
        (void)hipGetLastError();
        grid = cus * (per_cu < 1 ? per_cu : 1);
        if (grid <= 0) grid = -1;
    }
    if (grid < 0) return;
    p.ph_lo = 0; p.ph_hi = nph;
    hipLaunchKernelGGL(fwd, dim3(grid), dim3(NTHR), LDS_BYTES, stream, p);
#else
    for (int ph = 0; ph < nph; ++ph) {
        p.ph_lo = ph; p.ph_hi = ph + 1;
        hipLaunchKernelGGL(fwd, dim3(1024), dim3(NTHR), LDS_BYTES, stream, p);
    }
#endif
}
```

```cpp
#include <hip/hip_runtime.h>
#include <stdint.h>
#include <stdio.h>

typedef unsigned short bf16_t;
#ifndef ONE_LAUNCH
#define ONE_LAUNCH 1
#endif
#define DI __device__ __forceinline__

namespace cfg {
constexpr int B = 8, S = 2048, T = B * S, D = 1024;
constexpr int A_IN = 5376, B_INP = 2304;
constexpr int FF0 = 2816, FF1 = 3584, NE = 8;
constexpr int NMEM = 256;
constexpr int OUT_IN = 1280;
constexpr int NTHR = 512, NWAVE = 8;
constexpr int LDS_BYTES = 149504;
constexpr int P1_Q = 0, P1_CKV = 1024, P1_QIDX = 1280, P1_QC = 1792, P1_KIDX = 2048, P1_WIDX = 2112;
constexpr int P0_K = 3072, P0_V = 4096, P0_QC = 5120;
constexpr size_t RB_PROJ0 = 0, RB_MIXCAT = (size_t)T * A_IN * 2;
constexpr size_t RB_ACT0 = 0;
constexpr size_t RB_PROJ1 = 0, RB_KVFULL = (size_t)T * B_INP * 2, RB_CKV = RB_KVFULL + (size_t)T * 2048 * 2,
                 RB_BITMASK = RB_CKV + (size_t)T * 256 * 2, RB_IDX = RB_BITMASK + (size_t)T * 64 * 4, RB_L1END = RB_IDX + (size_t)T * 256 * 2;
constexpr size_t RB_ML = RB_MIXCAT + (size_t)T * OUT_IN * 2;
constexpr size_t RB_XB = RB_ML + (size_t)3 * T * 16 * 2 * 4;
constexpr size_t RB_MIN = RB_XB + (size_t)T * D * 2;
static_assert(RB_L1END <= RB_MIXCAT, "layer-1 scratch overlaps mixcat");
}
using namespace cfg;

struct P {
    const float *x, *mem, *rel_bias, *mem_norm, *final_norm, *mixer_norm, *ffn_norm, *w_mem_kv, *w_out;
    const float *e_w_in, *e_w_gate, *e_w_up, *e_w_down;
    const float *o_w_in, *o_kv_norm, *o_w_uk, *o_w_uv, *o_w_router, *o_w_gate, *o_w_up, *o_w_down;
    float* out;
    unsigned* ctl;
    float* biasd;
    bf16_t *Wt_in0, *Wt_gu0, *Wt_down0, *Wt_out, *Wt_in1, *Wt_memkv, *Wt_ukv, *Wt_gu1, *Wt_down1;
    bf16_t *memn, *kvmem, *hmoe, *ybuf;
    int *tok_e, *tok_pos; float* tok_g; int* lists;
    float *ssq, *ssqc;
    char* rb;
    int nsplit, ph_lo, ph_hi, pad;
};

constexpr int CTL_CNT = 4096;
constexpr int CTL_WORDS = 8192;

DI int otid() { int t = threadIdx.x; asm volatile("" : "+v"(t)); return t; }
DI float bf2f(bf16_t b) { return __uint_as_float(((unsigned)b) << 16); }
DI bf16_t f2bf(float f) { unsigned u = __float_as_uint(f); u += 0x7FFFu + ((u >> 16) & 1u); return (bf16_t)(u >> 16); }
DI float wave_sum(float v) { for (int o = 32; o >= 1; o >>= 1) v += __shfl_xor(v, o); return v; }
DI float wave_max(float v) { for (int o = 32; o >= 1; o >>= 1) v = fmaxf(v, __shfl_xor(v, o)); return v; }
DI void wave_lds_sync() { asm volatile("s_waitcnt lgkmcnt(0)" ::: "memory"); __builtin_amdgcn_wave_barrier(); asm volatile("" ::: "memory"); }

DI int colmap(int mode, int n, int& which) {
    which = 0;
    if (mode == 0) return n;
    if (mode == 1) { const int j = n >> 8, r = n & 255; which = (r >= 128); return j * 128 + (r & 127); }
    if (n < 1792) return n;
    if (n < 2048) return 1864 + (n - 1792);
    if (n < 2112) return 1792 + (n - 2048);
    if (n < 2120) return 1856 + (n - 2112);
    return -1;
}
struct ConvJob { const float* s0; const float* s1; const float* gk; bf16_t* dst; int ld, K, Nd, mode, t0, nk; };
DI void conv_all(const ConvJob* jobs  , int njobs, int total, char* smem) {
    bf16_t* tl = (bf16_t*)smem;
    const int tid = otid();
    const int kl = tid >> 6, n4 = (tid & 63) * 4, nl = tid >> 3, kc = (tid & 7) * 8;
    float4 r[8]; float gs[8];
    int cj = 0, ck0 = 0, cn0 = 0;
    auto locate = [&](int g, int& j, int& k0, int& n0) { j = 0; while (j + 1 < njobs && g >= jobs[j + 1].t0) ++j; const int lt = g - jobs[j].t0, nk = jobs[j].nk; k0 = (lt % nk) * 64; n0 = (lt / nk) * 256; };
    auto issue = [&](int j, int k0, int n0) {
        int which; const int c = colmap(jobs[j].mode, n0 + n4, which); const float* sp = which ? jobs[j].s1 : jobs[j].s0; const int ld = jobs[j].ld; const float* gk = jobs[j].gk;
#pragma unroll
        for (int i = 0; i < 8; ++i) { r[i] = (c >= 0) ? *(const float4*)(sp + (size_t)(k0 + kl + 8 * i) * ld + c) : make_float4(0.f, 0.f, 0.f, 0.f); gs[i] = gk ? gk[k0 + kl + 8 * i] : 1.f; }
    };
    int g = blockIdx.x, it = 0;
    if (g < total) { locate(g, cj, ck0, cn0); issue(cj, ck0, cn0); }
    for (; g < total; g += gridDim.x, ++it) {
        bf16_t* t = tl + (it & 1) * (256 * 72);
        const int j = cj, k0 = ck0, n0 = cn0;
#pragma unroll
        for (int i = 0; i < 8; ++i) { const float sc = gs[i]; const int kk = kl + 8 * i;
            t[(n4 + 0) * 72 + kk] = f2bf(r[i].x * sc); t[(n4 + 1) * 72 + kk] = f2bf(r[i].y * sc); t[(n4 + 2) * 72 + kk] = f2bf(r[i].z * sc); t[(n4 + 3) * 72 + kk] = f2bf(r[i].w * sc); }
        const int gn = g + gridDim.x;
        if (gn < total) { locate(gn, cj, ck0, cn0); issue(cj, ck0, cn0); }
        __syncthreads();
        bf16_t* dp = jobs[j].dst + (size_t)(n0 + nl) * jobs[j].K + k0 + kc; const size_t rs = (size_t)64 * jobs[j].K;
#pragma unroll
        for (int i = 0; i < 4; ++i) *(uint4*)(dp + i * rs) = *(const uint4*)(t + (nl + 64 * i) * 72 + kc);
    }
    __syncthreads();
}

DI void rms_rows_bf16(const float* src, int rows, const float* g, bf16_t* dst) {
    const int lane = otid() & 63, gw = blockIdx.x * NWAVE + (otid() >> 6), nw = gridDim.x * NWAVE;
    for (int r = gw; r < rows; r += nw) {
        const float4* s = (const float4*)(src + (size_t)r * D);
        float4 v[4]; float ss = 0.f;
#pragma unroll
        for (int i = 0; i < 4; ++i) { v[i] = s[lane + 64 * i]; ss += v[i].x * v[i].x + v[i].y * v[i].y + v[i].z * v[i].z + v[i].w * v[i].w; }
        ss = wave_sum(ss);
        const float rstd = rsqrtf(ss * (1.0f / D) + 1e-6f);
#pragma unroll
        for (int i = 0; i < 4; ++i) {
            const float4 gg = ((const float4*)g)[lane + 64 * i];
            ushort4 o; o.x = f2bf(v[i].x * rstd * gg.x); o.y = f2bf(v[i].y * rstd * gg.y); o.z = f2bf(v[i].z * rstd * gg.z); o.w = f2bf(v[i].w * rstd * gg.w);
            ((ushort4*)(dst + (size_t)r * D))[lane + 64 * i] = o;
        }
    }
}

#define XB_TMO      128
#define XB_XCNT(j)  (256  + 64 * (j))
#define XB_XSUB(j)  (1280 + 64 * (j))
#define XB_XGEN(j)  (2304 + 64 * (j))
#define XB_TOP      3328
#define XB_TOPGEN   3392
#define XCD_BAR_WORDS 3456
#define XB_SPIN_CAP (1u << 20)
#define LAS __attribute__((address_space(3)))
__device__ __forceinline__ unsigned xb_ld(unsigned* p)              { return __hip_atomic_load(p, __ATOMIC_RELAXED, __HIP_MEMORY_SCOPE_AGENT); }
__device__ __forceinline__ unsigned xb_add(unsigned* p, unsigned v) { return __hip_atomic_fetch_add(p, v, __ATOMIC_RELAXED, __HIP_MEMORY_SCOPE_AGENT); }
__device__ __forceinline__ unsigned xb_xcc_id() { return (unsigned)__builtin_amdgcn_s_getreg((3 << 11) | 20) & 0xFu; }
#define XB_SPIN(cond, bar) do { unsigned _sp = 0; while (cond) { __builtin_amdgcn_s_sleep(1); \
    if ((++_sp & 255u) == 0u) { if (xb_ld(&(bar)[XB_TMO])) break; if (_sp > XB_SPIN_CAP) { atomicAdd(&(bar)[XB_TMO], 1u); break; } } } } while (0)
struct XcdBarrier { unsigned* bar; unsigned x; volatile LAS unsigned* st; };
__device__ __forceinline__ XcdBarrier xcd_barrier_post(unsigned* bar, volatile LAS unsigned* st) {
    XcdBarrier b; b.bar = bar; b.x = xb_xcc_id(); b.st = st;
    if (threadIdx.x == 0) (void)xb_add(&bar[XB_XCNT(b.x)], 1u);
    return b;
}
__device__ __forceinline__ void xcd_barrier_complete(unsigned* bar, unsigned x, unsigned& nloc, unsigned& nx) {
    const unsigned G = gridDim.x * gridDim.y * gridDim.z;
    unsigned sum, cnt, mine, sp = 0u;
    for (;;) {
        sum = 0u; cnt = 0u; mine = 0u;
#pragma unroll
        for (unsigned j = 0; j < 16; ++j) { const unsigned c = xb_ld(&bar[XB_XCNT(j)]); sum += c; cnt += (c > 0u) ? 1u : 0u; mine = (j == x) ? c : mine; }
        if (sum == G) break;
        __builtin_amdgcn_s_sleep(1);
        if ((++sp & 255u) == 0u) { if (xb_ld(&bar[XB_TMO])) break; if (sp > XB_SPIN_CAP) { atomicAdd(&bar[XB_TMO], 1u); break; } }
    }
    nloc = mine > 0u ? mine : 1u; nx = cnt > 0u ? cnt : 1u;
}
__device__ __forceinline__ void xcd_barrier(const XcdBarrier& b) {
    asm volatile("s_waitcnt vmcnt(0)" ::: "memory");
    __syncthreads();
    if (threadIdx.x == 0) {
        unsigned* bar = b.bar;
        __builtin_amdgcn_s_waitcnt(0);
        unsigned nloc = b.st[0], nx = b.st[1];
        if (nloc == 0u) { xcd_barrier_complete(bar, b.x, nloc, nx); b.st[0] = nloc; b.st[1] = nx; }
        const unsigned old = xb_add(&bar[XB_XSUB(b.x)], 1u);
        const unsigned gen = old / nloc;
        if (old + 1u == (gen + 1u) * nloc) {
            __builtin_amdgcn_fence(__ATOMIC_RELEASE, "agent");
            asm volatile("s_waitcnt vmcnt(0)" ::: "memory");
            const unsigned og = xb_add(&bar[XB_TOP], 1u);
            const unsigned tg = og / nx;
            if (og + 1u == (tg + 1u) * nx) xb_add(&bar[XB_TOPGEN], 1u);
            else XB_SPIN(xb_ld(&bar[XB_TOPGEN]) == tg, bar);
            __builtin_amdgcn_fence(__ATOMIC_ACQUIRE, "agent");
            xb_add(&bar[XB_XGEN(b.x)], 1u);
            asm volatile("s_waitcnt vmcnt(0)" ::: "memory");
        } else {
            XB_SPIN(xb_ld(&bar[XB_XGEN(b.x)]) == gen, bar);
            __builtin_amdgcn_fence(__ATOMIC_ACQUIRE, "agent");
            asm volatile("s_waitcnt vmcnt(0)" ::: "memory");
        }
    }
    __syncthreads();
}


namespace pg8 {
typedef short bf16x8 __attribute__((ext_vector_type(8)));
typedef float f32x4 __attribute__((ext_vector_type(4)));
typedef unsigned u32x4 __attribute__((ext_vector_type(4)));
constexpr int BM = 256, BK = 64, HALF = 128, HTB = HALF * BK * 2, STAGE_BYTES = 8 * HTB, NXCD = 8, WGM = 8;
DI int lds_byte(int r, int c) { const int st = (r >> 4) * 2 + (c >> 5), rr = r & 15, cc = c & 31, ob = rr * 64 + cc * 2; return st * 1024 + (ob ^ (((ob >> 9) & 1) << 5)); }
DI void stage_rc(int b, int& R, int& C) { const int st = b / 1024, sb = b % 1024, swz = sb ^ (((sb >> 9) & 1) << 5); R = (st >> 1) * 16 + swz / 64; C = (st & 1) * 32 + (swz % 64) / 2; }
DI int perm32(int rho) { const int n = rho >> 4, i = rho & 15; return 8 * (i >> 2) + 4 * n + (i & 3); }
struct Unit { int pm, pn, pb, e, mt, nvalid; };
struct Gemm { const bf16_t* A; const bf16_t* Bt; int K; int lda; };
struct StaticOrder {
    int nM, nN, nwg, G, c;
    DI void init(int M, int N, int G_, int c_) { nM = M / BM; nN = N / BM; nwg = nM * nN; G = G_; c = c_; }
    DI bool next(int i, Unit& u) const {
        const long L = (long)i * G + c; if (L >= nwg) return false;
        int wgid = (int)L; { const int q = nwg / NXCD, r = nwg % NXCD, xcd = wgid % NXCD, off = wgid / NXCD; wgid = (xcd < r ? xcd * (q + 1) : r * (q + 1) + (xcd - r) * q) + off; }
        const int nig = WGM * nN, gid = wgid / nig, fm = gid * WGM, gsz = (nM - fm) < WGM ? (nM - fm) : WGM;
        u.pm = fm + ((wgid % nig) % gsz); u.pn = (wgid % nig) / gsz; u.pb = u.pn; u.e = 0; u.mt = u.pm; u.nvalid = 256; return true;
    }
    DI const int* rowlist(const Unit&) const { return nullptr; }
};
struct GroupOrder {
    int nN, G, c, total, Tc; const int* lists;
    int tiles[8], toff[8], cnt[8];
    DI bool next(int i, Unit& u) const {
        const long L = (long)i * G + c; if (L >= total) return false;
        int l = (int)L, ee = 0, te = 1, toe = 0, ce = 0; bool found = false;
#pragma unroll
        for (int j = 0; j < 8; ++j) { const int n = tiles[j] * nN; if (!found) { if (l < n) { found = true; ee = j; te = tiles[j]; toe = toff[j]; ce = cnt[j]; } else l -= n; } }
        u.e = ee; u.mt = l % te; u.pn = l / te; u.pm = toe + u.mt; u.pb = ee * nN + u.pn; const int nv = ce - u.mt * 256; u.nvalid = nv < 256 ? nv : 256; return true;
    }
    DI const int* rowlist(const Unit& u) const { return lists + (size_t)u.e * Tc + u.mt * 256; }
};
DI unsigned cvt_pk_bf16(float lo, float hi) { unsigned r; asm volatile("v_cvt_pk_bf16_f32 %0, %1, %2" : "=v"(r) : "v"(lo), "v"(hi)); return r; }
struct EpiBf16 {
    static constexpr bool PERM = true;
    bf16_t* O; int ldc;
    DI void operator()(const f32x4 (&acc)[2][2][4][2], const Unit& u, int wr, int wc, int fr, int fq) const {
        const int row0 = u.pm * BM + wr * 64 + fr, col0 = u.pn * BM + wc * 32 + 8 * fq;
#pragma unroll
        for (int ai = 0; ai < 2; ++ai)
#pragma unroll
            for (int m = 0; m < 4; ++m) { bf16_t* rowp = O + (size_t)(row0 + ai * HALF + m * 16) * ldc + col0;
#pragma unroll
                for (int bj = 0; bj < 2; ++bj) { const f32x4 v0 = acc[ai][bj][m][0], v1 = acc[ai][bj][m][1];
                    u32x4 w; w.x = cvt_pk_bf16(v0[0], v0[1]); w.y = cvt_pk_bf16(v0[2], v0[3]); w.z = cvt_pk_bf16(v1[0], v1[1]); w.w = cvt_pk_bf16(v1[2], v1[3]);
                    *(u32x4*)(rowp + bj * HALF) = w; } }
    }
};
struct EpiResid {
    static constexpr bool PERM = false;
    const float* base; float* out;
    DI void operator()(const f32x4 (&acc)[2][2][4][2], const Unit& u, int wr, int wc, int fr, int fq) const {
        const int row0 = u.pm * BM + wr * 64 + fr, col0 = u.pn * BM + wc * 32 + 4 * fq;
#pragma unroll
        for (int ai = 0; ai < 2; ++ai)
#pragma unroll
            for (int m = 0; m < 4; ++m) { const size_t off = (size_t)(row0 + ai * HALF + m * 16) * 1024 + col0;
#pragma unroll
                for (int bj = 0; bj < 2; ++bj)
#pragma unroll
                    for (int n = 0; n < 2; ++n) { const f32x4 bs = *(const f32x4*)(base + off + bj * HALF + n * 16); *(f32x4*)(out + off + bj * HALF + n * 16) = bs + acc[ai][bj][m][n]; }
                asm volatile("" ::: "memory"); }
    }
};
struct EpiSwiglu {
    static constexpr bool PERM = true;
    bf16_t* O; int ldc;
    DI static float act(float g, float u) { return g * __builtin_amdgcn_rcpf(1.0f + __expf(-g)) * u; }
    DI void operator()(const f32x4 (&acc)[2][2][4][2], const Unit& u, int wr, int wc, int fr, int fq) const {
        const int row0 = u.pm * BM + wr * 64 + fr, col0 = u.pn * HALF + wc * 32 + 8 * fq;
#pragma unroll
        for (int ai = 0; ai < 2; ++ai)
#pragma unroll
            for (int m = 0; m < 4; ++m) { bf16_t* rowp = O + (size_t)(row0 + ai * HALF + m * 16) * ldc + col0;
                const f32x4 g0 = acc[ai][0][m][0], g1 = acc[ai][0][m][1], u0 = acc[ai][1][m][0], u1 = acc[ai][1][m][1];
                u32x4 w; w.x = cvt_pk_bf16(act(g0[0], u0[0]), act(g0[1], u0[1])); w.y = cvt_pk_bf16(act(g0[2], u0[2]), act(g0[3], u0[3]));
                w.z = cvt_pk_bf16(act(g1[0], u1[0]), act(g1[1], u1[1])); w.w = cvt_pk_bf16(act(g1[2], u1[2]), act(g1[3], u1[3]));
                *(u32x4*)rowp = w; }
    }
};

constexpr int LDS_PART = STAGE_BYTES;
DI float rstd_of(const float* ssq, int row) { const f32x4 v = *(const f32x4*)(ssq + (size_t)row * 4); return rsqrtf(((v[0] + v[1]) + (v[2] + v[3])) * (1.0f / 1024.0f) + 1e-6f); }
DI void row_reduce_store(LAS unsigned char* lds, const float (&s)[2][4], int wr, int wc, int fr, int fq, float* dst, int dstride) {
    LAS float* part = (LAS float*)(lds + LDS_PART);
#pragma unroll
    for (int ai = 0; ai < 2; ++ai)
#pragma unroll
        for (int m = 0; m < 4; ++m) { float v = s[ai][m]; v += __shfl_xor(v, 16); v += __shfl_xor(v, 32); if (fq == 0) part[(ai * HALF + wr * 64 + m * 16 + fr) * 4 + wc] = v; }
    asm volatile("s_waitcnt lgkmcnt(0)" ::: "memory"); __builtin_amdgcn_s_barrier(); asm volatile("" ::: "memory");
    const int t = threadIdx.x;
    if (t < 256) { const float a = part[t * 4 + 0], b = part[t * 4 + 1], c = part[t * 4 + 2], d = part[t * 4 + 3]; dst[(size_t)t * dstride] = (a + b) + (c + d); }
    asm volatile("s_waitcnt lgkmcnt(0)" ::: "memory"); __builtin_amdgcn_s_barrier(); asm volatile("" ::: "memory");
}
struct EpiResidNorm {
    static constexpr bool PERM = true;
    const float* base; float* out; bf16_t* xb; float* ssq; LAS unsigned char* lds;
    DI void operator()(const f32x4 (&acc)[2][2][4][2], const Unit& u, int wr, int wc, int fr, int fq) const {
        const int row0 = u.pm * BM + wr * 64 + fr, col0 = u.pn * BM + wc * 32 + 8 * fq;
        float sq[2][4];
#pragma unroll
        for (int ai = 0; ai < 2; ++ai)
#pragma unroll
            for (int m = 0; m < 4; ++m) { const size_t off = (size_t)(row0 + ai * HALF + m * 16) * 1024 + col0; float s = 0.f;
#pragma unroll
                for (int bj = 0; bj < 2; ++bj) {
                    const f32x4 v0 = *(const f32x4*)(base + off + bj * HALF) + acc[ai][bj][m][0], v1 = *(const f32x4*)(base + off + bj * HALF + 4) + acc[ai][bj][m][1];
                    *(f32x4*)(out + off + bj * HALF) = v0; *(f32x4*)(out + off + bj * HALF + 4) = v1;
                    u32x4 w; w.x = cvt_pk_bf16(v0[0], v0[1]); w.y = cvt_pk_bf16(v0[2], v0[3]); w.z = cvt_pk_bf16(v1[0], v1[1]); w.w = cvt_pk_bf16(v1[2], v1[3]);
                    *(u32x4*)(xb + off + bj * HALF) = w;
                    s += (v0[0] * v0[0] + v0[1] * v0[1]) + (v0[2] * v0[2] + v0[3] * v0[3]) + (v1[0] * v1[0] + v1[1] * v1[1]) + (v1[2] * v1[2] + v1[3] * v1[3]); }
                sq[ai][m] = s; asm volatile("" ::: "memory"); }
        row_reduce_store(lds, sq, wr, wc, fr, fq, ssq + (size_t)u.pm * BM * 4 + u.pn, 4);
    }
};
struct EpiSwigluN {
    static constexpr bool PERM = true;
    bf16_t* O; int ldc; const float* ssq;
    DI void operator()(const f32x4 (&acc)[2][2][4][2], const Unit& u, int wr, int wc, int fr, int fq) const {
        const int row0 = u.pm * BM + wr * 64 + fr, col0 = u.pn * HALF + wc * 32 + 8 * fq;
#pragma unroll
        for (int ai = 0; ai < 2; ++ai)
#pragma unroll
            for (int m = 0; m < 4; ++m) { const int row = row0 + ai * HALF + m * 16; const float rs = rstd_of(ssq, row); bf16_t* rowp = O + (size_t)row * ldc + col0;
                const f32x4 g0 = acc[ai][0][m][0] * rs, g1 = acc[ai][0][m][1] * rs, u0 = acc[ai][1][m][0] * rs, u1 = acc[ai][1][m][1] * rs;
                u32x4 w; w.x = cvt_pk_bf16(EpiSwiglu::act(g0[0], u0[0]), EpiSwiglu::act(g0[1], u0[1])); w.y = cvt_pk_bf16(EpiSwiglu::act(g0[2], u0[2]), EpiSwiglu::act(g0[3], u0[3]));
                w.z = cvt_pk_bf16(EpiSwiglu::act(g1[0], u1[0]), EpiSwiglu::act(g1[1], u1[1])); w.w = cvt_pk_bf16(EpiSwiglu::act(g1[2], u1[2]), EpiSwiglu::act(g1[3], u1[3]));
                *(u32x4*)rowp = w; }
    }
};
struct EpiBf16N {
    static constexpr bool PERM = true;
    bf16_t* O; int ldc; const float* ssq; float* ssqc; int ctile; LAS unsigned char* lds;
    DI void operator()(const f32x4 (&acc)[2][2][4][2], const Unit& u, int wr, int wc, int fr, int fq) const {
        const int row0 = u.pm * BM + wr * 64 + fr, col0 = u.pn * BM + wc * 32 + 8 * fq;
        float sq[2][4];
#pragma unroll
        for (int ai = 0; ai < 2; ++ai)
#pragma unroll
            for (int m = 0; m < 4; ++m) { const int row = row0 + ai * HALF + m * 16; const float rs = rstd_of(ssq, row); bf16_t* rowp = O + (size_t)row * ldc + col0; float s = 0.f;
#pragma unroll
                for (int bj = 0; bj < 2; ++bj) { const f32x4 v0 = acc[ai][bj][m][0] * rs, v1 = acc[ai][bj][m][1] * rs;
                    u32x4 w; w.x = cvt_pk_bf16(v0[0], v0[1]); w.y = cvt_pk_bf16(v0[2], v0[3]); w.z = cvt_pk_bf16(v1[0], v1[1]); w.w = cvt_pk_bf16(v1[2], v1[3]);
                    *(u32x4*)(rowp + bj * HALF) = w;
                    s += (v0[0] * v0[0] + v0[1] * v0[1]) + (v0[2] * v0[2] + v0[3] * v0[3]) + (v1[0] * v1[0] + v1[1] * v1[1]) + (v1[2] * v1[2] + v1[3] * v1[3]); }
                sq[ai][m] = s; }
        if (u.pn == ctile) row_reduce_store(lds, sq, wr, wc, fr, fq, ssqc + (size_t)u.pm * BM, 1);
    }
};
struct EpiBf16C {
    static constexpr bool PERM = true;
    bf16_t* O; int ldc; const float* ssqc;
    DI void operator()(const f32x4 (&acc)[2][2][4][2], const Unit& u, int wr, int wc, int fr, int fq) const {
        const int row0 = u.pm * BM + wr * 64 + fr, col0 = u.pn * BM + wc * 32 + 8 * fq;
#pragma unroll
        for (int ai = 0; ai < 2; ++ai)
#pragma unroll
            for (int m = 0; m < 4; ++m) { const int row = row0 + ai * HALF + m * 16; const float rs = rsqrtf(ssqc[row] * (1.0f / 256.0f) + 1e-6f); bf16_t* rowp = O + (size_t)row * ldc + col0;
#pragma unroll
                for (int bj = 0; bj < 2; ++bj) { const f32x4 v0 = acc[ai][bj][m][0] * rs, v1 = acc[ai][bj][m][1] * rs;
                    u32x4 w; w.x = cvt_pk_bf16(v0[0], v0[1]); w.y = cvt_pk_bf16(v0[2], v0[3]); w.z = cvt_pk_bf16(v1[0], v1[1]); w.w = cvt_pk_bf16(v1[2], v1[3]);
                    *(u32x4*)(rowp + bj * HALF) = w; } }
    }
};

template <class Epi, class Sched, bool ALIGN_EPI, bool GATHER>
DI void gemm_phase(LAS unsigned char* lds, const Gemm g, const Sched& S, const Epi& E) {
    int tid_ = threadIdx.x; asm volatile("" : "+v"(tid_));
    const int tid = tid_, wid = __builtin_amdgcn_readfirstlane(tid >> 6), lane = tid & 63, wr = wid >> 2, wc = wid & 3, fr = lane & 15, fq = lane >> 4;
    const int K = g.K, nt = K / BK;
    unsigned voffB[2];
#pragma unroll
    for (int i = 0; i < 2; ++i) { int R, C; stage_rc(tid * 16 + i * 8192, R, C); const int Rb = Epi::PERM ? ((R & ~31) + perm32(R & 31)) : R; voffB[i] = (unsigned)(Rb * K + C) * 2u; }
    const size_t kstep = (size_t)(BK * 2);
    const size_t hstep = (size_t)HALF * K * 2;
    const size_t tstep = 2 * hstep;
    const int lda = g.lda; const size_t hstepA = (size_t)HALF * lda * 2, tstepA = 2 * hstepA;
    const size_t hA = GATHER ? (size_t)0 : hstepA;
    const unsigned ldsw = (unsigned)wid * 1024u;
    const int aoff = lds_byte(wr * 64 + fr, fq * 8), boff = lds_byte(wc * 32 + fr, fq * 8);
#define PG8_SA(b, h) (((b) * 2 + (h)) * HTB)
#define PG8_SB(b, h) ((4 + (b) * 2 + (h)) * HTB)
#define PG8_STAGE(bufoff, gbase, voff) do { _Pragma("unroll") for (int _i = 0; _i < 2; ++_i) \
        __builtin_amdgcn_global_load_lds((const unsigned*)((const char*)(gbase) + (voff)[_i]), (LAS unsigned*)(lds + (bufoff) + ldsw + _i * 8192), 16, 0, 0); } while (0)
#define PG8_LDA(dst, b, h) do { _Pragma("unroll") for (int m = 0; m < 4; ++m) _Pragma("unroll") for (int k = 0; k < 2; ++k) dst[m][k] = *(const LAS bf16x8*)(lds + PG8_SA(b, h) + aoff + m * 2048 + k * 1024); } while (0)
#define PG8_LDB(dst, b, h) do { _Pragma("unroll") for (int n = 0; n < 2; ++n) _Pragma("unroll") for (int k = 0; k < 2; ++k) dst[n][k] = *(const LAS bf16x8*)(lds + PG8_SB(b, h) + boff + n * 2048 + k * 1024); } while (0)
#define PG8_MMA(ai, bj, At, Bt) do { __builtin_amdgcn_s_setprio(1); _Pragma("unroll") for (int m = 0; m < 4; ++m) _Pragma("unroll") for (int n = 0; n < 2; ++n) _Pragma("unroll") for (int k = 0; k < 2; ++k) \
        acc[ai][bj][m][n] = __builtin_amdgcn_mfma_f32_16x16x32_bf16(Bt[n][k], At[m][k], acc[ai][bj][m][n], 0, 0, 0); __builtin_amdgcn_s_setprio(0); } while (0)
#define PG8_WAIT_V(n) asm volatile("s_waitcnt vmcnt(" #n ")" ::: "memory")
#define PG8_WAIT_L(n) asm volatile("s_waitcnt lgkmcnt(" #n ")" ::: "memory")
#define PG8_BAR __builtin_amdgcn_s_barrier()
#define PG8_SCHED __builtin_amdgcn_sched_barrier(0)
#define PG8_AOFFS(u, o0, o1, base) do { \
        if constexpr (GATHER) { const int* _rl = S.rowlist(u); _Pragma("unroll") for (int _i = 0; _i < 2; ++_i) { int _R, _C; stage_rc(tid * 16 + _i * 8192, _R, _C); \
                const int _r0 = _R, _r1 = _R + HALF; const int _t0 = _rl[_r0 < (u).nvalid ? _r0 : 0], _t1 = _rl[_r1 < (u).nvalid ? _r1 : 0]; \
                o0[_i] = (unsigned)(_t0 * lda + _C) * 2u; o1[_i] = (unsigned)(_t1 * lda + _C) * 2u; } base = (const char*)g.A; } \
        else { _Pragma("unroll") for (int _i = 0; _i < 2; ++_i) { int _R, _C; stage_rc(tid * 16 + _i * 8192, _R, _C); o0[_i] = (unsigned)(_R * lda + _C) * 2u; o1[_i] = o0[_i]; } base = (const char*)g.A + (size_t)(u).pm * tstepA; } } while (0)
    Unit cur, nxt; int ui = 0;
    if (!S.next(0, cur)) return;
    f32x4 acc[2][2][4][2];
#pragma unroll
    for (int a = 0; a < 2; ++a)
#pragma unroll
        for (int b = 0; b < 2; ++b)
#pragma unroll
            for (int m = 0; m < 4; ++m)
#pragma unroll
                for (int n = 0; n < 2; ++n) acc[a][b][m][n] = (f32x4){0.f, 0.f, 0.f, 0.f};
    bf16x8 At[4][2], B0[2][2], B1[2][2];
    unsigned vA0[2], vA1[2], nA0[2], nA1[2];
    const char* cA; const char* cB = (const char*)g.Bt + (size_t)cur.pb * tstep;
    PG8_AOFFS(cur, vA0, vA1, cA);
    PG8_STAGE(PG8_SB(0, 0), cB, voffB); PG8_STAGE(PG8_SB(0, 1), cB + hstep, voffB); PG8_STAGE(PG8_SA(0, 0), cA, vA0); PG8_STAGE(PG8_SA(0, 1), cA + hA, vA1);
    if (wr == 1) PG8_BAR;
    PG8_WAIT_V(2); PG8_BAR;
    PG8_STAGE(PG8_SB(1, 0), cB + kstep, voffB); PG8_STAGE(PG8_SA(1, 0), cA + kstep, vA0); PG8_STAGE(PG8_SB(1, 1), cB + hstep + kstep, voffB);
    PG8_WAIT_V(6); PG8_BAR;
    for (;;) {
        const bool has_next = S.next(ui + 1, nxt);
        const char* nA = cA; const char* nB = has_next ? (const char*)g.Bt + (size_t)nxt.pb * tstep : cB;
#pragma unroll
        for (int i = 0; i < 2; ++i) { nA0[i] = vA0[i]; nA1[i] = vA1[i]; }
        if (has_next) PG8_AOFFS(nxt, nA0, nA1, nA);
#pragma unroll 1
        for (int t = 0; t < nt; t += 2) {
            const bool last = (t == nt - 2);
            const char* a1 = cA + (size_t)(t + 1) * kstep;
            const char* a2 = last ? nA : cA + (size_t)(t + 2) * kstep; const char* b2 = last ? nB : cB + (size_t)(t + 2) * kstep;
            const char* a3 = a2 + kstep; const char* b3 = b2 + kstep;
            unsigned s0[2], s1[2];
#pragma unroll
            for (int i = 0; i < 2; ++i) { s0[i] = (GATHER && last) ? nA0[i] : vA0[i]; s1[i] = (GATHER && last) ? nA1[i] : vA1[i]; }
            PG8_LDB(B0, 0, 0); PG8_LDB(B1, 0, 1); PG8_SCHED; PG8_LDA(At, 0, 0); PG8_STAGE(PG8_SA(1, 1), a1 + hA, vA1);
            PG8_WAIT_V(8); PG8_WAIT_L(0); PG8_BAR; PG8_MMA(0, 0, At, B0); PG8_MMA(0, 1, At, B1); PG8_BAR; PG8_SCHED;
            PG8_LDA(At, 0, 1); PG8_STAGE(PG8_SB(0, 0), b2, voffB); PG8_STAGE(PG8_SB(0, 1), b2 + hstep, voffB); PG8_STAGE(PG8_SA(0, 0), a2, s0);
            PG8_WAIT_V(8); PG8_WAIT_L(0); PG8_BAR; PG8_MMA(1, 0, At, B0); PG8_MMA(1, 1, At, B1); PG8_BAR; PG8_SCHED;
            PG8_LDB(B0, 1, 0); PG8_LDB(B1, 1, 1); PG8_SCHED; PG8_LDA(At, 1, 0); PG8_STAGE(PG8_SA(0, 1), a2 + hA, s1);
            PG8_WAIT_V(8); PG8_WAIT_L(0); PG8_BAR; PG8_MMA(0, 0, At, B0); PG8_MMA(0, 1, At, B1); PG8_BAR; PG8_SCHED;
            PG8_LDA(At, 1, 1); PG8_STAGE(PG8_SB(1, 0), b3, voffB); PG8_STAGE(PG8_SB(1, 1), b3 + hstep, voffB); PG8_STAGE(PG8_SA(1, 0), a3, s0);
            PG8_WAIT_V(8); PG8_WAIT_L(0); PG8_BAR; PG8_MMA(1, 0, At, B0); PG8_MMA(1, 1, At, B1); PG8_BAR; PG8_SCHED;
        }
        if constexpr (ALIGN_EPI) { if (wr == 0) PG8_BAR; }
        E(acc, cur, wr, wc, fr, fq);
        if (!has_next) break;
#pragma unroll
        for (int a = 0; a < 2; ++a)
#pragma unroll
            for (int b = 0; b < 2; ++b)
#pragma unroll
                for (int m = 0; m < 4; ++m)
#pragma unroll
                    for (int n = 0; n < 2; ++n) acc[a][b][m][n] = (f32x4){0.f, 0.f, 0.f, 0.f};
        cur = nxt; cA = nA; cB = nB; ++ui;
#pragma unroll
        for (int i = 0; i < 2; ++i) { vA0[i] = nA0[i]; vA1[i] = nA1[i]; }
        if constexpr (ALIGN_EPI) { if (wr == 1) PG8_BAR; }
    }
    PG8_WAIT_V(0);
    if constexpr (!ALIGN_EPI) { if (wr == 0) PG8_BAR; }
    PG8_BAR;
#undef PG8_SA
#undef PG8_SB
#undef PG8_STAGE
#undef PG8_LDA
#undef PG8_LDB
#undef PG8_MMA
#undef PG8_WAIT_V
#undef PG8_WAIT_L
#undef PG8_BAR
#undef PG8_SCHED
#undef PG8_AOFFS
}
}


namespace fa {
typedef short bf16x8 __attribute__((ext_vector_type(8)));
typedef short s16x4 __attribute__((ext_vector_type(4)));
typedef float f32x16 __attribute__((ext_vector_type(16)));
typedef unsigned u32x4 __attribute__((ext_vector_type(4)));
typedef float f32x2_t __attribute__((ext_vector_type(2))); typedef __bf16 bf16x2_t __attribute__((ext_vector_type(2)));
typedef short v4i16_t __attribute__((ext_vector_type(4)));
DI unsigned cvtpk(float lo, float hi) { f32x2_t v = {lo, hi}; bf16x2_t b = __builtin_convertvector(v, bf16x2_t); return __builtin_bit_cast(unsigned, b); }
DI s16x4 vtr(const LAS unsigned char* p) { return __builtin_bit_cast(s16x4, __builtin_amdgcn_ds_read_tr16_b64_v4i16((LAS v4i16_t*)p)); }
constexpr float LOG2E = 1.4426950408889634f, C2 = 0.125f * LOG2E, NEGB = -1.0e30f;
constexpr int VSTR = 192, VIMG = 32 * VSTR;

template <int MODE>
DI void flash_unit(const bf16_t* qrow, const bf16_t* kbase, const bf16_t* vbase, long krs, int st_begin, int st_end,
                   const LAS float* tbl, const unsigned* bmrow, LAS unsigned char* vimg, f32x16& o0, f32x16& o1, float& m_out, float& l_out) {
    const int lane = otid() & 63, r32 = lane & 31, hi = lane >> 5;
    bf16x8 qf[4];
#pragma unroll
    for (int ks = 0; ks < 4; ++ks) qf[ks] = *(const bf16x8*)(qrow + 16 * ks + 8 * hi);
    const int vrow0 = lane >> 3, vch = lane & 7;
    LAS unsigned char* vw = vimg + vrow0 * VSTR + vch * 16;
    const LAS unsigned char* vrd = vimg + (4 * hi + ((lane & 15) >> 2)) * VSTR + ((lane >> 4) & 1) * 32 + (lane & 3) * 8;
#pragma unroll
    for (int i = 0; i < 16; ++i) { o0[i] = 0.f; o1[i] = 0.f; }
    float m = NEGB, l = 0.f;
    bf16x8 kf[4]; u32x4 vr[4]; unsigned bw = 0u;
    {
        const bf16_t* kp = kbase + (long)(32 * st_begin + r32) * krs + 8 * hi;
#pragma unroll
        for (int ks = 0; ks < 4; ++ks) kf[ks] = *(const bf16x8*)(kp + 16 * ks);
#pragma unroll
        for (int j = 0; j < 4; ++j) vr[j] = *(const u32x4*)(vbase + (long)(32 * st_begin + vrow0 + 8 * j) * krs + vch * 8);
        if (MODE == 2) bw = bmrow[st_begin];
    }
    for (int st = st_begin; st < st_end; ++st) {
        bf16x8 kc[4]; u32x4 vc[4];
#pragma unroll
        for (int ks = 0; ks < 4; ++ks) kc[ks] = kf[ks];
#pragma unroll
        for (int j = 0; j < 4; ++j) vc[j] = vr[j];
        const unsigned bwc = bw;
        if (st + 1 < st_end) {
            const bf16_t* kp = kbase + (long)(32 * (st + 1) + r32) * krs + 8 * hi;
#pragma unroll
            for (int ks = 0; ks < 4; ++ks) kf[ks] = *(const bf16x8*)(kp + 16 * ks);
#pragma unroll
            for (int j = 0; j < 4; ++j) vr[j] = *(const u32x4*)(vbase + (long)(32 * (st + 1) + vrow0 + 8 * j) * krs + vch * 8);
            if (MODE == 2) bw = bmrow[st + 1];
        }
#pragma unroll
        for (int j = 0; j < 4; ++j) *(LAS u32x4*)(vw + j * 8 * VSTR) = vc[j];
        f32x16 sv;
#pragma unroll
        for (int i = 0; i < 16; ++i) sv[i] = 0.f;
#pragma unroll
        for (int ks = 0; ks < 4; ++ks) sv = __builtin_amdgcn_mfma_f32_32x32x16_bf16(kc[ks], qf[ks], sv, 0, 0, 0);
        float mx = NEGB;
        const unsigned bws = bwc >> (4 * hi);
#pragma unroll
        for (int i = 0; i < 16; ++i) {
            const int ci = (i & 3) + 8 * (i >> 2);
            float x;
            if (MODE == 0) x = sv[i] * C2;
            else x = __builtin_fmaf(sv[i], C2, tbl[32 * st + ci]);
            if (MODE == 2) x = ((bws >> ci) & 1u) ? x : NEGB;
            sv[i] = x; mx = fmaxf(mx, x);
        }
        mx = fmaxf(mx, __shfl_xor(mx, 32));
        const float mn = fmaxf(m, mx);
        if (__builtin_amdgcn_ballot_w64(mn > m) != 0ull) {
            const float al = __builtin_amdgcn_exp2f(m - mn);
            l *= al; m = mn;
#pragma unroll
            for (int i = 0; i < 16; ++i) { o0[i] *= al; o1[i] *= al; }
        }
        float ps = 0.f;
#pragma unroll
        for (int i = 0; i < 16; ++i) { const float pe = __builtin_amdgcn_exp2f(sv[i] - m); sv[i] = pe; ps += pe; }
        ps += __shfl_xor(ps, 32); l += ps;
        u32x4 w0, w1;
        w0.x = cvtpk(sv[0], sv[1]); w0.y = cvtpk(sv[2], sv[3]); w0.z = cvtpk(sv[4], sv[5]); w0.w = cvtpk(sv[6], sv[7]);
        w1.x = cvtpk(sv[8], sv[9]); w1.y = cvtpk(sv[10], sv[11]); w1.z = cvtpk(sv[12], sv[13]); w1.w = cvtpk(sv[14], sv[15]);
        const bf16x8 pb0 = __builtin_bit_cast(bf16x8, w0), pb1 = __builtin_bit_cast(bf16x8, w1);
#pragma unroll
        for (int dt = 0; dt < 2; ++dt) {
            const s16x4 a0 = vtr(vrd + dt * 64), a1 = vtr(vrd + 8 * VSTR + dt * 64), a2 = vtr(vrd + 16 * VSTR + dt * 64), a3 = vtr(vrd + 24 * VSTR + dt * 64);
            const bf16x8 v0 = (bf16x8){a0[0], a0[1], a0[2], a0[3], a1[0], a1[1], a1[2], a1[3]};
            const bf16x8 v1 = (bf16x8){a2[0], a2[1], a2[2], a2[3], a3[0], a3[1], a3[2], a3[3]};
            if (dt == 0) { o0 = __builtin_amdgcn_mfma_f32_32x32x16_bf16(v0, pb0, o0, 0, 0, 0); o0 = __builtin_amdgcn_mfma_f32_32x32x16_bf16(v1, pb1, o0, 0, 0, 0); }
            else         { o1 = __builtin_amdgcn_mfma_f32_32x32x16_bf16(v0, pb0, o1, 0, 0, 0); o1 = __builtin_amdgcn_mfma_f32_32x32x16_bf16(v1, pb1, o1, 0, 0, 0); }
        }
    }
    m_out = m; l_out = l;
}
DI void store_o(bf16_t* orow, const f32x16& o0, const f32x16& o1, float sc, int hi) {
#pragma unroll
    for (int g = 0; g < 4; ++g) {
        uint2 a, b2;
        a.x = cvtpk(o0[4 * g] * sc, o0[4 * g + 1] * sc); a.y = cvtpk(o0[4 * g + 2] * sc, o0[4 * g + 3] * sc);
        b2.x = cvtpk(o1[4 * g] * sc, o1[4 * g + 1] * sc); b2.y = cvtpk(o1[4 * g + 2] * sc, o1[4 * g + 3] * sc);
        *(uint2*)(orow + 8 * g + 4 * hi) = a; *(uint2*)(orow + 32 + 8 * g + 4 * hi) = b2;
    }
}
}

constexpr int NPH = 20;

DI void ph_prologue(const P& p, char* smem) {
    ConvJob* jobs = (ConvJob*)(smem + 2 * 256 * 72 * 2);
    if (otid() == 0) {
        int n = 0, t0 = 0;
        auto add = [&](const float* s0, const float* s1, const float* gk, bf16_t* dst, int ld, int K, int Nd, int mode) {
            ConvJob j; j.s0 = s0; j.s1 = s1; j.gk = gk; j.dst = dst; j.ld = ld; j.K = K; j.Nd = Nd; j.mode = mode; j.t0 = t0; j.nk = K / 64; jobs[n] = j; ++n; t0 += (K / 64) * (Nd / 256); };
        add(p.e_w_in, nullptr, nullptr, p.Wt_in0, A_IN, D, A_IN, 0);
        add(p.e_w_gate, p.e_w_up, p.ffn_norm, p.Wt_gu0, FF0, D, 2 * FF0, 1);
        add(p.e_w_down, nullptr, nullptr, p.Wt_down0, D, FF0, D, 0);
        add(p.w_out, nullptr, nullptr, p.Wt_out, D, OUT_IN, D, 0);
        add(p.w_out + (size_t)OUT_IN * D, nullptr, nullptr, p.Wt_out + (size_t)D * OUT_IN, D, OUT_IN, D, 0);
        add(p.o_w_in, nullptr, p.mixer_norm + D, p.Wt_in1, 2120, D, B_INP, 2);
        add(p.w_mem_kv, nullptr, nullptr, p.Wt_memkv, 512, D, 512, 0);
        add(p.w_mem_kv + (size_t)D * 512, nullptr, nullptr, p.Wt_memkv + (size_t)512 * D, 512, D, 512, 0);
        add(p.o_w_uk, nullptr, p.o_kv_norm, p.Wt_ukv, 1024, 256, 1024, 0);
        add(p.o_w_uv, nullptr, p.o_kv_norm, p.Wt_ukv + (size_t)1024 * 256, 1024, 256, 1024, 0);
        for (int e = 0; e < NE; ++e) {
            add(p.o_w_gate + (size_t)e * D * FF1, p.o_w_up + (size_t)e * D * FF1, nullptr, p.Wt_gu1 + (size_t)e * 2 * FF1 * D, FF1, D, 2 * FF1, 1);
            add(p.o_w_down + (size_t)e * FF1 * D, nullptr, nullptr, p.Wt_down1 + (size_t)e * D * FF1, D, FF1, D, 0);
        }
        jobs[n].t0 = t0;
        ((int*)(jobs + 32))[0] = n;
    }
    __syncthreads();
    { const int n = ((const int*)(jobs + 32))[0]; conv_all(jobs, n, jobs[n].t0, smem); }
    for (int i = blockIdx.x * NTHR + otid(); i < 2049 * 16; i += gridDim.x * NTHR) {
        const int dist = i >> 4, hh = i & 15; int bucket;
        if (dist < 16) bucket = dist;
        else { const float nf = (float)dist; int lg = 16 + (int)(logf(nf / 16.0f) / logf(128.0f) * 16.0f); bucket = lg < 31 ? lg : 31; }
        p.biasd[i] = p.rel_bias[bucket * 16 + hh];
    }
    rms_rows_bf16(p.mem, B * NMEM, p.mem_norm, p.memn);
    rms_rows_bf16(p.x, T, p.mixer_norm, (bf16_t*)(p.rb + RB_XB));
}


DI void ph_proj0(const P& p, LAS unsigned char* lds) {
    { pg8::Gemm g{p.memn, p.Wt_memkv, D, D}; pg8::StaticOrder S; S.init(B * NMEM, 1024, (int)gridDim.x, (int)blockIdx.x); pg8::EpiBf16 E{p.kvmem, 1024};
      pg8::gemm_phase<pg8::EpiBf16, pg8::StaticOrder, true, false>(lds, g, S, E); }
    { pg8::Gemm g{(const bf16_t*)(p.rb + RB_XB), p.Wt_in0, D, D}; pg8::StaticOrder S; S.init(T, A_IN, (int)gridDim.x, (int)blockIdx.x); pg8::EpiBf16 E{(bf16_t*)(p.rb + RB_PROJ0), A_IN};
      pg8::gemm_phase<pg8::EpiBf16, pg8::StaticOrder, true, false>(lds, g, S, E); }
}

DI void cross_flash(const P& p, int li, const bf16_t* proj, int ldp, int qoff, LAS unsigned char* lds) {
    const int tid = otid(), lane = tid & 63, wid = __builtin_amdgcn_readfirstlane(tid >> 6), r32 = lane & 31, hi = lane >> 5;
    LAS unsigned char* vimg = lds + wid * fa::VIMG;
    bf16_t* mixcat = (bf16_t*)(p.rb + RB_MIXCAT);
    const int gw = blockIdx.x * NWAVE + wid, nw = gridDim.x * NWAVE;
    for (int u = gw; u < B * 4 * 64; u += nw) {
        const int tt = u & 63, hc = (u >> 6) & 3, b = u >> 8;
        const size_t trow = (size_t)b * S + 32 * tt + r32;
        const bf16_t* kb = p.kvmem + (size_t)b * NMEM * 1024 + li * 512 + hc * 64;
        fa::f32x16 o0, o1; float m, l;
        fa::flash_unit<0>(proj + trow * ldp + qoff + hc * 64, kb, kb + 256, 1024, 0, 8, nullptr, nullptr, vimg, o0, o1, m, l);
        fa::store_o(mixcat + trow * OUT_IN + 1024 + hc * 64, o0, o1, 1.0f / l, hi);
    }
}

DI void ph_attn0(const P& p, LAS unsigned char* lds, bool dry = false) {
    const int tid = otid(), lane = tid & 63, wid = __builtin_amdgcn_readfirstlane(tid >> 6), r32 = lane & 31, hi = lane >> 5;
    LAS unsigned char* vimg = lds + wid * fa::VIMG;
    LAS float* rtb = (LAS float*)(lds + NWAVE * fa::VIMG);
    bf16_t* proj0 = (bf16_t*)(p.rb + RB_PROJ0);
    float* ml = (float*)(p.rb + RB_ML);
    for (int job = blockIdx.x; job < 256; job += gridDim.x) {
        const int b = job >> 5, head = (job >> 1) & 15, hf = job & 1;
        __syncthreads();
        for (int k = tid; k < 3 * 192; k += NTHR) { const int g = k / 192, j = 159 - (k - g * 192), d = (g == 0) ? 1 : (g == 1 ? 4 : 16);
            rtb[k] = (j >= 0 && j <= 128) ? p.biasd[(j * d) * 16 + head] * fa::LOG2E : fa::NEGB; }
        __syncthreads();
#pragma unroll 1
        for (int n = wid; n < 96; n += NWAVE) {
            const int g = n >> 5, qt = 2 * (n & 31) + hf, dsh = 2 * g, d = 1 << dsh;
            const int tpr = 64 >> dsh, r = qt / tpr, mt = qt - r * tpr, m0 = 32 * mt;
            const size_t tokq = (size_t)b * S + (size_t)(m0 + r32) * d + r;
            bf16_t* qrow = proj0 + tokq * A_IN + g * 1024 + head * 64;
            const bf16_t* kb = proj0 + ((long)b * S + r + (long)(m0 - 128) * d) * (long)A_IN + P0_K + head * 64;
            fa::f32x16 o0, o1; float m, l;
            fa::flash_unit<1>(qrow, kb, kb + (P0_V - P0_K), (long)d * A_IN, (mt >= 4) ? 0 : 4 - mt, 5, rtb + g * 192 + (31 - r32 + 4 * hi), nullptr, vimg, o0, o1, m, l);
            fa::store_o(dry ? (bf16_t*)(p.rb + RB_MIXCAT) + (tokq * OUT_IN + head * 64) : qrow, o0, o1, 1.0f / l, hi);
            if (hi == 0) *(float2*)(ml + (((size_t)g * T + tokq) * 16 + head) * 2) = make_float2(m, l);
        }
    }
    __syncthreads();
    cross_flash(p, 0, proj0, A_IN, P0_QC, lds);
}
DI void ph_comb0(const P& p) {
    const int tid = otid(), lane = tid & 63, gw = blockIdx.x * NWAVE + (tid >> 6), nw = gridDim.x * NWAVE;
    const bf16_t* proj0 = (const bf16_t*)(p.rb + RB_PROJ0); const float* ml = (const float*)(p.rb + RB_ML);
    bf16_t* mixcat = (bf16_t*)(p.rb + RB_MIXCAT);
    for (int t = gw; t < T; t += nw) {
        const int head = lane >> 2;
        float mg[3], lg[3];
#pragma unroll
        for (int g = 0; g < 3; ++g) { const float2 v = *(const float2*)(ml + (((size_t)g * T + t) * 16 + head) * 2); mg[g] = v.x; lg[g] = v.y; }
        const float M = fmaxf(mg[0], fmaxf(mg[1], mg[2]));
        float w[3], ws = 0.f;
#pragma unroll
        for (int g = 0; g < 3; ++g) { w[g] = __builtin_amdgcn_exp2f(mg[g] - M) * lg[g]; ws += w[g]; }
        const float inv = 1.0f / ws;
        float acc[16];
#pragma unroll
        for (int j = 0; j < 16; ++j) acc[j] = 0.f;
#pragma unroll
        for (int g = 0; g < 3; ++g) {
            const uint4 v0 = *(const uint4*)(proj0 + (size_t)t * A_IN + g * 1024 + lane * 16), v1 = *(const uint4*)(proj0 + (size_t)t * A_IN + g * 1024 + lane * 16 + 8);
            const unsigned wd[8] = {v0.x, v0.y, v0.z, v0.w, v1.x, v1.y, v1.z, v1.w}; const float wg = w[g] * inv;
#pragma unroll
            for (int j = 0; j < 8; ++j) { acc[2 * j] += wg * __uint_as_float(wd[j] << 16); acc[2 * j + 1] += wg * __uint_as_float(wd[j] & 0xffff0000u); }
        }
        uint4 o0, o1;
        o0.x = fa::cvtpk(acc[0], acc[1]); o0.y = fa::cvtpk(acc[2], acc[3]); o0.z = fa::cvtpk(acc[4], acc[5]); o0.w = fa::cvtpk(acc[6], acc[7]);
        o1.x = fa::cvtpk(acc[8], acc[9]); o1.y = fa::cvtpk(acc[10], acc[11]); o1.z = fa::cvtpk(acc[12], acc[13]); o1.w = fa::cvtpk(acc[14], acc[15]);
        *(uint4*)(mixcat + (size_t)t * OUT_IN + lane * 16) = o0; *(uint4*)(mixcat + (size_t)t * OUT_IN + lane * 16 + 8) = o1;
    }
}

DI void ph_outproj(const P& p, int li, LAS unsigned char* lds) {
    pg8::Gemm g{(const bf16_t*)(p.rb + RB_MIXCAT), p.Wt_out + (size_t)li * D * OUT_IN, OUT_IN, OUT_IN}; pg8::StaticOrder S; S.init(T, D, (int)gridDim.x, (int)blockIdx.x);
    if (li == 0) { pg8::EpiResidNorm E{p.x, p.out, (bf16_t*)(p.rb + RB_XB), p.ssq, lds}; pg8::gemm_phase<pg8::EpiResidNorm, pg8::StaticOrder, true, false>(lds, g, S, E); }
    else { pg8::EpiResid E{p.out, p.out}; pg8::gemm_phase<pg8::EpiResid, pg8::StaticOrder, true, false>(lds, g, S, E); }
}
DI void ph_gateup0(const P& p, LAS unsigned char* lds) {
    pg8::Gemm g{(const bf16_t*)(p.rb + RB_XB), p.Wt_gu0, D, D}; pg8::StaticOrder S; S.init(T, 2 * FF0, (int)gridDim.x, (int)blockIdx.x); pg8::EpiSwigluN E{(bf16_t*)(p.rb + RB_ACT0), FF0, p.ssq};
    pg8::gemm_phase<pg8::EpiSwigluN, pg8::StaticOrder, true, false>(lds, g, S, E);
}
DI void ph_down0(const P& p, LAS unsigned char* lds) {
    pg8::Gemm g{(const bf16_t*)(p.rb + RB_ACT0), p.Wt_down0, FF0, FF0}; pg8::StaticOrder S; S.init(T, D, (int)gridDim.x, (int)blockIdx.x);
    pg8::EpiResidNorm E{p.out, p.out, (bf16_t*)(p.rb + RB_XB), p.ssq, lds};
    pg8::gemm_phase<pg8::EpiResidNorm, pg8::StaticOrder, true, false>(lds, g, S, E);
}
DI void ph_proj1(const P& p, LAS unsigned char* lds) {
    pg8::Gemm g{(const bf16_t*)(p.rb + RB_XB), p.Wt_in1, D, D}; pg8::StaticOrder S; S.init(T, B_INP, (int)gridDim.x, (int)blockIdx.x);
    pg8::EpiBf16N E{(bf16_t*)(p.rb + RB_PROJ1), B_INP, p.ssq, p.ssqc, P1_CKV / 256, lds};
    pg8::gemm_phase<pg8::EpiBf16N, pg8::StaticOrder, true, false>(lds, g, S, E);
}

DI void ph_kvfull(const P& p, LAS unsigned char* lds) {
    pg8::Gemm g{(const bf16_t*)(p.rb + RB_PROJ1) + P1_CKV, p.Wt_ukv, 256, B_INP}; pg8::StaticOrder S; S.init(T, 2048, (int)gridDim.x, (int)blockIdx.x); pg8::EpiBf16C E{(bf16_t*)(p.rb + RB_KVFULL), 2048, p.ssqc};
    pg8::gemm_phase<pg8::EpiBf16C, pg8::StaticOrder, true, false>(lds, g, S, E);
}

DI void ph_topk(const P& p, char* smem) {
    constexpr int SCS = 2052;
    float* sc = (float*)smem;
    const int tid = otid(), lane = tid & 63, wid = __builtin_amdgcn_readfirstlane(tid >> 6);
    const bf16_t* proj1 = (const bf16_t*)(p.rb + RB_PROJ1);
    unsigned* bitmask = (unsigned*)(p.rb + RB_BITMASK);
    typedef short bf16x8 __attribute__((ext_vector_type(8))); typedef float f32x4 __attribute__((ext_vector_type(4)));
    for (int u0 = blockIdx.x, rnd = 0; u0 < T / 16; u0 += gridDim.x, ++rnd) {
        const int u = (rnd & 1) ? ((u0 & ~127) | (127 - (u0 & 127))) : u0;
        const int t0 = u * 16, b = t0 / S, tl0 = t0 % S, tmax = tl0 + 15;
        {
            const int qn = lane & 15, g4 = lane >> 4;
            const bf16_t* qrow = proj1 + (size_t)(t0 + qn) * B_INP;
            bf16x8 qf[8][2]; float wq[8];
#pragma unroll
            for (int hh = 0; hh < 8; ++hh) {
#pragma unroll
                for (int ks = 0; ks < 2; ++ks) qf[hh][ks] = *(const bf16x8*)(qrow + P1_QIDX + hh * 64 + 32 * ks + 8 * g4);
                wq[hh] = bf2f(qrow[P1_WIDX + hh]) * (0.35355339059327373f * 0.125f);
            }
            const int ntile = (tmax >> 4) + 1;
            const bf16_t* kbase = proj1 + ((size_t)b * S + qn) * B_INP + P1_KIDX + 8 * g4;
            bf16x8 kn0, kn1;
            if (wid < ntile) { kn0 = *(const bf16x8*)(kbase + (size_t)(16 * wid) * B_INP); kn1 = *(const bf16x8*)(kbase + (size_t)(16 * wid) * B_INP + 32); }
#pragma unroll 1
            for (int kt = wid; kt < ntile; kt += NWAVE) {
                const bf16x8 k0 = kn0, k1 = kn1;
                if (kt + NWAVE < ntile) { kn0 = *(const bf16x8*)(kbase + (size_t)(16 * (kt + NWAVE)) * B_INP); kn1 = *(const bf16x8*)(kbase + (size_t)(16 * (kt + NWAVE)) * B_INP + 32); }
                f32x4 acc = (f32x4){0.f, 0.f, 0.f, 0.f};
#pragma unroll
                for (int hh = 0; hh < 8; ++hh) {
                    f32x4 dd = (f32x4){0.f, 0.f, 0.f, 0.f};
                    dd = __builtin_amdgcn_mfma_f32_16x16x32_bf16(k0, qf[hh][0], dd, 0, 0, 0);
                    dd = __builtin_amdgcn_mfma_f32_16x16x32_bf16(k1, qf[hh][1], dd, 0, 0, 0);
#pragma unroll
                    for (int i = 0; i < 4; ++i) acc[i] += wq[hh] * fmaxf(dd[i], 0.f);
                }
#pragma unroll
                for (int i = 0; i < 4; ++i) acc[i] += 0.0f;
                *(f32x4*)(sc + qn * SCS + 16 * kt + 4 * g4) = acc;
            }
        }
        __syncthreads();
#pragma unroll 1
        for (int rr = 0; rr < 2; ++rr) {
            const int qi = wid * 2 + rr, t = t0 + qi, tl = tl0 + qi;
            unsigned uu[32];
#pragma unroll
            for (int i = 0; i < 32; ++i) {
                const int key = lane + 64 * i;
                unsigned v = 0u;
                if (key <= tl) { const unsigned bits = __float_as_uint(sc[qi * SCS + key]); v = (bits & 0x80000000u) ? ~bits : (bits | 0x80000000u); }
                uu[i] = v;
            }
            unsigned T_ = 0u; int need_eq = 0; bool all_causal = (tl + 1 <= 256);
            if (!all_causal) {
                unsigned v = 0u; bool exact = false;
#pragma unroll 1
                for (int bit = 31; bit >= 0; --bit) {
                    const unsigned cand = v | (1u << bit);
                    int cnt = 0;
#pragma unroll
                    for (int i = 0; i < 32; ++i) cnt += __builtin_popcountll(__ballot(uu[i] >= cand));
                    if (cnt >= 256) { v = cand; if (cnt == 256) { exact = true; break; } }
                }
                T_ = v;
                if (!exact) {
                    int ngt = 0;
#pragma unroll
                    for (int i = 0; i < 32; ++i) ngt += __builtin_popcountll(__ballot(uu[i] > T_));
                    need_eq = 256 - ngt;
                } else need_eq = -1;
            }
            unsigned myword = 0u; int taken = 0;
#pragma unroll
            for (int i = 0; i < 32; ++i) {
                const int key = lane + 64 * i;
                unsigned long long m;
                if (all_causal) m = __ballot(key <= tl);
                else if (need_eq < 0) m = __ballot(uu[i] >= T_);
                else {
                    const unsigned long long g = __ballot(uu[i] > T_); unsigned long long e = __ballot(uu[i] == T_);
                    const int c = __builtin_popcountll(e);
                    if (taken + c > need_eq) { unsigned long long sel = 0ull; int k2 = need_eq - taken; while (k2 > 0) { const unsigned long long low = e & (0ull - e); sel |= low; e ^= low; --k2; } e = sel; taken = need_eq; }
                    else taken += c;
                    m = g | e;
                }
                if (lane == 2 * i) myword = (unsigned)m;
                if (lane == 2 * i + 1) myword = (unsigned)(m >> 32);
            }
            bitmask[(size_t)t * 64 + lane] = myword;
        }
        __syncthreads();
    }
}

DI void ph_attn1(const P& p, LAS unsigned char* lds) {
    const int tid = otid(), lane = tid & 63, wid = __builtin_amdgcn_readfirstlane(tid >> 6), r32 = lane & 31, hi = lane >> 5;
    LAS unsigned char* vimg = lds + wid * fa::VIMG;
    LAS float* rtb = (LAS float*)(lds + NWAVE * fa::VIMG);
    const bf16_t* proj1 = (const bf16_t*)(p.rb + RB_PROJ1); const bf16_t* kvfull = (const bf16_t*)(p.rb + RB_KVFULL);
    const unsigned* bitmask = (const unsigned*)(p.rb + RB_BITMASK);
    bf16_t* mixcat = (bf16_t*)(p.rb + RB_MIXCAT);
    for (int job = blockIdx.x; job < 256; job += gridDim.x) {
        const int b = job >> 5, head = (job >> 1) & 15, hf = job & 1;
        __syncthreads();
        for (int k = tid; k < 2080; k += NTHR) { const int dist = 2047 - k; rtb[k] = (dist >= 0) ? p.biasd[dist * 16 + head] * fa::LOG2E : 0.f; }
        __syncthreads();
#pragma unroll 1
        for (int qi = 0; qi < 4; ++qi) {
            const int kk = (qi == 0) ? wid : (qi == 1) ? 15 - wid : (qi == 2) ? 16 + wid : 31 - wid;
            const int tt = hf + 2 * kk, tq = 32 * tt + r32;
            const size_t trow = (size_t)b * S + tq;
            const bf16_t* kb = kvfull + (size_t)b * S * 2048 + head * 64;
            fa::f32x16 o0, o1; float m, l;
            fa::flash_unit<2>(proj1 + trow * B_INP + P1_Q + head * 64, kb, kb + 1024, 2048, 0, tt + 1, rtb + (2047 - tq + 4 * hi), bitmask + trow * 64, vimg, o0, o1, m, l);
            fa::store_o(mixcat + trow * OUT_IN + head * 64, o0, o1, 1.0f / l, hi);
        }
    }
    __syncthreads();
    cross_flash(p, 1, proj1, B_INP, P1_QC, lds);
}

DI void ph_router(const P& p) {
    const int lane = otid() & 63, gw = blockIdx.x * NWAVE + (otid() >> 6), nw = gridDim.x * NWAVE;
    const int Tc = T / p.nsplit;
    const float* g = p.ffn_norm + D;
    for (int t = gw; t < T; t += nw) {
        const float4* s = (const float4*)(p.out + (size_t)t * D);
        float4 v[4]; float ss = 0.f;
#pragma unroll
        for (int i = 0; i < 4; ++i) { v[i] = s[lane + 64 * i]; ss += v[i].x * v[i].x + v[i].y * v[i].y + v[i].z * v[i].z + v[i].w * v[i].w; }
        ss = wave_sum(ss);
        const float rstd = rsqrtf(ss * (1.0f / D) + 1e-6f);
        float lg[8];
#pragma unroll
        for (int e = 0; e < 8; ++e) lg[e] = 0.f;
#pragma unroll
        for (int i = 0; i < 4; ++i) {
            const float4 gg = ((const float4*)g)[lane + 64 * i];
            const float hv[4] = {v[i].x * rstd * gg.x, v[i].y * rstd * gg.y, v[i].z * rstd * gg.z, v[i].w * rstd * gg.w};
            ushort4 o; o.x = f2bf(hv[0]); o.y = f2bf(hv[1]); o.z = f2bf(hv[2]); o.w = f2bf(hv[3]);
            ((ushort4*)(p.hmoe + (size_t)t * D))[lane + 64 * i] = o;
#pragma unroll
            for (int j = 0; j < 4; ++j) {
                const int k = (lane + 64 * i) * 4 + j;
                const float4 w0 = *(const float4*)(p.o_w_router + (size_t)k * 8), w1 = *(const float4*)(p.o_w_router + (size_t)k * 8 + 4);
                lg[0] += hv[j] * w0.x; lg[1] += hv[j] * w0.y; lg[2] += hv[j] * w0.z; lg[3] += hv[j] * w0.w;
                lg[4] += hv[j] * w1.x; lg[5] += hv[j] * w1.y; lg[6] += hv[j] * w1.z; lg[7] += hv[j] * w1.w;
            }
        }
#pragma unroll
        for (int e = 0; e < 8; ++e) lg[e] = wave_sum(lg[e]);
        if (lane == 0) {
            int e1 = 0; float v1 = lg[0];
#pragma unroll
            for (int e = 1; e < 8; ++e) if (lg[e] > v1) { v1 = lg[e]; e1 = e; }
            int e2 = -1; float v2 = -3.0e38f;
#pragma unroll
            for (int e = 0; e < 8; ++e) if (e != e1 && lg[e] > v2) { v2 = lg[e]; e2 = e; }
            const float ex = __expf(v2 - v1); const float g1 = 1.0f / (1.0f + ex), g2 = ex / (1.0f + ex);
            const int c = t / Tc;
            const int p1 = (int)atomicAdd(p.ctl + CTL_CNT + c * 8 + e1, 1u), p2 = (int)atomicAdd(p.ctl + CTL_CNT + c * 8 + e2, 1u);
            p.lists[((size_t)c * 8 + e1) * Tc + p1] = t; p.lists[((size_t)c * 8 + e2) * Tc + p2] = t;
            p.tok_e[t * 2] = e1; p.tok_e[t * 2 + 1] = e2; p.tok_pos[t * 2] = p1; p.tok_pos[t * 2 + 1] = p2; p.tok_g[t * 2] = g1; p.tok_g[t * 2 + 1] = g2;
        }
    }
}

DI void moe_offsets(const P& p, int c, int (&cnt)[8], int (&off)[8]) {
    int o = 0;
#pragma unroll
    for (int e = 0; e < 8; ++e) { cnt[e] = (int)__hip_atomic_load(p.ctl + CTL_CNT + c * 8 + e, __ATOMIC_RELAXED, __HIP_MEMORY_SCOPE_AGENT); off[e] = o; o += (cnt[e] + 255) & ~255; }
}
DI size_t moe_rowcap(const P& p) { return (size_t)(2 * (T / p.nsplit) + 2048); }

DI void moe_order(const P& p, int c, int nN, pg8::GroupOrder& S) {
    int cnt[8], off[8]; moe_offsets(p, c, cnt, off);
    S.nN = nN; S.G = (int)gridDim.x; S.c = (int)blockIdx.x; S.Tc = T / p.nsplit; S.lists = p.lists + (size_t)c * 8 * S.Tc;
    int tot = 0;
#pragma unroll
    for (int e = 0; e < 8; ++e) { S.cnt[e] = cnt[e]; S.tiles[e] = (cnt[e] + 255) >> 8; S.toff[e] = off[e] >> 8; tot += S.tiles[e] * nN; }
    S.total = tot;
}
DI void ph_moe_gateup(const P& p, int c, LAS unsigned char* lds) {
    pg8::GroupOrder S; moe_order(p, c, 2 * FF1 / 256, S);
    pg8::Gemm g{p.hmoe, p.Wt_gu1, D, D}; pg8::EpiSwiglu E{(bf16_t*)p.rb, FF1};
    pg8::gemm_phase<pg8::EpiSwiglu, pg8::GroupOrder, true, true>(lds, g, S, E);
}
DI void ph_moe_down(const P& p, int c, LAS unsigned char* lds) {
    pg8::GroupOrder S; moe_order(p, c, D / 256, S);
    pg8::Gemm g{(const bf16_t*)p.rb, p.Wt_down1, FF1, FF1}; pg8::EpiBf16 E{p.ybuf, D};
    pg8::gemm_phase<pg8::EpiBf16, pg8::GroupOrder, true, false>(lds, g, S, E);
}
DI void ph_moe_combine(const P& p, int c) {
    int cnt[8], off[8]; moe_offsets(p, c, cnt, off);
    const int Tc = T / p.nsplit;
    const bf16_t* ybuf = p.ybuf;
    const int lane = otid() & 63, gw = blockIdx.x * NWAVE + (otid() >> 6), nw = gridDim.x * NWAVE;
    for (int tt = gw; tt < Tc; tt += nw) {
        const int t = c * Tc + tt;
        const int e1 = p.tok_e[t * 2], e2 = p.tok_e[t * 2 + 1]; const float g1 = p.tok_g[t * 2], g2 = p.tok_g[t * 2 + 1];
        int o1 = 0, o2 = 0;
#pragma unroll
        for (int e = 0; e < 8; ++e) { if (e == e1) o1 = off[e]; if (e == e2) o2 = off[e]; }
        const bf16_t* y1 = ybuf + (size_t)(o1 + p.tok_pos[t * 2]) * D; const bf16_t* y2 = ybuf + (size_t)(o2 + p.tok_pos[t * 2 + 1]) * D;
        float4* xo = (float4*)(p.out + (size_t)t * D);
        float4 v[4]; float ss = 0.f;
#pragma unroll
        for (int i = 0; i < 4; ++i) {
            v[i] = xo[lane + 64 * i];
            const ushort4 a = ((const ushort4*)y1)[lane + 64 * i], bq = ((const ushort4*)y2)[lane + 64 * i];
            v[i].x += g1 * bf2f(a.x) + g2 * bf2f(bq.x); v[i].y += g1 * bf2f(a.y) + g2 * bf2f(bq.y); v[i].z += g1 * bf2f(a.z) + g2 * bf2f(bq.z); v[i].w += g1 * bf2f(a.w) + g2 * bf2f(bq.w);
            ss += v[i].x * v[i].x + v[i].y * v[i].y + v[i].z * v[i].z + v[i].w * v[i].w;
        }
        ss = wave_sum(ss);
        const float rstd = rsqrtf(ss * (1.0f / D) + 1e-6f);
#pragma unroll
        for (int i = 0; i < 4; ++i) {
            const float4 gg = ((const float4*)p.final_norm)[lane + 64 * i];
            xo[lane + 64 * i] = make_float4(v[i].x * rstd * gg.x, v[i].y * rstd * gg.y, v[i].z * rstd * gg.z, v[i].w * rstd * gg.w);
        }
    }
}

enum { PH_PRO = 0, PH_PROJ0, PH_ATTN0, PH_COMB0, PH_OUT0, PH_GU0, PH_DOWN0, PH_PROJ1, PH_KVTOPK, PH_ATTN1, PH_OUT1, PH_ROUTER, PH_MOE0 };

__global__ void __launch_bounds__(NTHR, 2) fwd(P p) {
    extern __shared__ __attribute__((aligned(16))) unsigned char lds[];
    char* smem = (char*)lds;
    LAS unsigned char* l3 = (LAS unsigned char*)lds;
    const int lo = p.ph_lo, hi = p.ph_hi;
    volatile LAS unsigned* stw = (volatile LAS unsigned*)((LAS unsigned char*)lds + (LDS_BYTES - 16));
    if (threadIdx.x < 4) stw[threadIdx.x] = 0u;
    __syncthreads();
    XcdBarrier bar; bar.bar = p.ctl; bar.x = 0; bar.st = stw;
    const bool fused = (hi - lo) > 1;
    if (fused) bar = xcd_barrier_post(p.ctl, stw);
#ifndef DUP_PH
#define DUP_PH -1
#endif
#define IN(k) (lo <= (k) && (k) < hi)
#define SEAM(k) do { if (IN(k) && IN((k) + 1)) xcd_barrier(bar); } while (0)
#define RUN(k, call) do { if (IN(k)) { call; if (DUP_PH == (k)) { call; } } SEAM(k); } while (0)
    RUN(PH_PRO, ph_prologue(p, smem));
    RUN(PH_PROJ0, ph_proj0(p, l3));
    if (IN(PH_ATTN0)) { if (DUP_PH == PH_ATTN0) ph_attn0(p, l3, true); ph_attn0(p, l3); }
    SEAM(PH_ATTN0);
    RUN(PH_COMB0, ph_comb0(p));
    if (IN(PH_OUT0)) ph_outproj(p, 0, l3);
    SEAM(PH_OUT0);
    RUN(PH_GU0, ph_gateup0(p, l3));
    if (IN(PH_DOWN0)) ph_down0(p, l3);
    SEAM(PH_DOWN0);
    RUN(PH_PROJ1, ph_proj1(p, l3));
    if (IN(PH_KVTOPK)) { ph_kvfull(p, l3); ph_topk(p, smem); if (DUP_PH == PH_KVTOPK) { ph_topk(p, smem); } }
    SEAM(PH_KVTOPK);
    RUN(PH_ATTN1, ph_attn1(p, l3));
    if (IN(PH_OUT1)) ph_outproj(p, 1, l3);
    SEAM(PH_OUT1);
    if (IN(PH_ROUTER)) ph_router(p);
    SEAM(PH_ROUTER);
    for (int c = 0; c < p.nsplit; ++c) {
        const int base = PH_MOE0 + 3 * c;
        RUN(base, ph_moe_gateup(p, c, l3));
        RUN(base + 1, ph_moe_down(p, c, l3));
        if (IN(base + 2)) ph_moe_combine(p, c);
        if (c + 1 < p.nsplit) SEAM(base + 2);
    }
#undef IN
#undef SEAM
#undef RUN
}

static size_t align_up(size_t v, size_t a) { return (v + a - 1) / a * a; }

extern "C" void kernel_launch(void* const* d_in, const int* in_sizes, int n_in, void* d_out, int out_size, void* d_ws, size_t ws_size, hipStream_t stream) {
    (void)in_sizes; (void)n_in; (void)out_size;
    P p{};
    p.x = (const float*)d_in[0]; p.mem = (const float*)d_in[1]; p.rel_bias = (const float*)d_in[2]; p.mem_norm = (const float*)d_in[3];
    p.final_norm = (const float*)d_in[4]; p.mixer_norm = (const float*)d_in[5]; p.ffn_norm = (const float*)d_in[6]; p.w_mem_kv = (const float*)d_in[7];
    p.w_out = (const float*)d_in[8]; p.e_w_in = (const float*)d_in[9]; p.e_w_gate = (const float*)d_in[10]; p.e_w_up = (const float*)d_in[11];
    p.e_w_down = (const float*)d_in[12]; p.o_w_in = (const float*)d_in[13]; p.o_kv_norm = (const float*)d_in[14]; p.o_w_uk = (const float*)d_in[15];
    p.o_w_uv = (const float*)d_in[16]; p.o_w_router = (const float*)d_in[17]; p.o_w_gate = (const float*)d_in[18]; p.o_w_up = (const float*)d_in[19];
    p.o_w_down = (const float*)d_in[20];
    p.out = (float*)d_out;
    char* ws = (char*)d_ws; size_t o = 0;
    auto take = [&](size_t bytes) { char* r = ws + o; o = align_up(o + bytes, 256); return r; };
    p.ctl = (unsigned*)take(CTL_WORDS * 4);
    p.biasd = (float*)take(2049 * 16 * 4);
    p.Wt_in0 = (bf16_t*)take((size_t)A_IN * D * 2);
    p.Wt_gu0 = (bf16_t*)take((size_t)2 * FF0 * D * 2);
    p.Wt_down0 = (bf16_t*)take((size_t)D * FF0 * 2);
    p.Wt_in1 = (bf16_t*)take((size_t)B_INP * D * 2);
    p.Wt_memkv = (bf16_t*)take((size_t)2 * 512 * D * 2);
    p.Wt_ukv = (bf16_t*)take((size_t)2048 * 256 * 2);
    p.Wt_out = (bf16_t*)take((size_t)2 * D * OUT_IN * 2);
    p.hmoe = p.Wt_in0;
    if ((size_t)((char*)p.Wt_out - (char*)p.Wt_in0) < (size_t)T * D * 2) { fprintf(stderr, "kernel_launch: layout error (hmoe overlay)\n"); return; }
    p.Wt_gu1 = (bf16_t*)take((size_t)NE * 2 * FF1 * D * 2);
    p.Wt_down1 = (bf16_t*)take((size_t)NE * D * FF1 * 2);
    p.memn = (bf16_t*)take((size_t)B * NMEM * D * 2);
    p.kvmem = (bf16_t*)take((size_t)B * NMEM * 1024 * 2);
    p.tok_e = (int*)take((size_t)T * 2 * 4); p.tok_pos = (int*)take((size_t)T * 2 * 4); p.tok_g = (float*)take((size_t)T * 2 * 4);
    p.lists = (int*)take((size_t)NE * T * 4);
    p.ssq = (float*)take((size_t)T * 4 * 4); p.ssqc = (float*)take((size_t)T * 4);
    p.rb = take(0);
    const size_t fixed = o;
    int nsplit = 1;
    for (; nsplit <= 8; nsplit *= 2) {
        const size_t rowcap = (size_t)(2 * (T / nsplit) + 2048);
        size_t need = rowcap * FF1 * 2 + (nsplit == 1 ? 0 : rowcap * D * 2); if (need < RB_MIN) need = RB_MIN;
        if (fixed + need <= ws_size) break;
    }
    if (nsplit > 8) { fprintf(stderr, "kernel_launch: workspace too small (%zu)\n", ws_size); return; }
    p.nsplit = nsplit;
    p.ybuf = (nsplit == 1) ? p.Wt_gu1 : (bf16_t*)(p.rb + (size_t)(2 * (T / nsplit) + 2048) * FF1 * 2);
    static bool attr = false;
    if (!attr) { (void)hipFuncSetAttribute((const void*)fwd, hipFuncAttributeMaxDynamicSharedMemorySize, LDS_BYTES); attr = true; }
    (void)hipMemsetAsync(p.ctl, 0, CTL_WORDS * 4, stream);
    const int nph = PH_MOE0 + 3 * nsplit;
#if ONE_LAUNCH
    static int grid = 0;
    if (!grid) {
        int dev = 0, cus = 0, per_cu = 0;
        (void)hipGetDevice(&dev);
        (void)hipDeviceGetAttribute(&cus, hipDeviceAttributeMultiprocessorCount, dev);
        (void)hipOccupancyMaxActiveBlocksPerMultiprocessor(&per_cu, (const void*)fwd, NTHR, LDS_BYTES);
        (void)hipGetLastError();
        grid = cus * (per_cu < 1 ? per_cu : 1);
        if (grid <= 0) grid = -1;
    }
    if (grid < 0) return;
    p.ph_lo = 0; p.ph_hi = nph;
    hipLaunchKernelGGL(fwd, dim3(grid), dim3(NTHR), LDS_BYTES, stream, p);
#else
    for (int ph = 0; ph < nph; ++ph) {
        p.ph_lo = ph; p.ph_hi = ph + 1;
        hipLaunchKernelGGL(fwd, dim3(1024), dim3(NTHR), LDS_BYTES, stream, p);
    }
#endif
}
```

```cpp
#include <hip/hip_runtime.h>
#include <stdint.h>
#include <stdio.h>

typedef unsigned short bf16_t;
#ifndef ONE_LAUNCH
#define ONE_LAUNCH 1
#endif
#define DI __device__ __forceinline__

namespace cfg {
constexpr int B = 8, S = 2048, T = B * S, D = 1024;
constexpr int A_IN = 5376, B_INP = 2304;
constexpr int FF0 = 2816, FF1 = 3584, NE = 8;
constexpr int NMEM = 256;
constexpr int OUT_IN = 1280;
constexpr int NTHR = 512, NWAVE = 8;
constexpr int LDS_BYTES = 149504;
constexpr int P1_Q = 0, P1_CKV = 1024, P1_QIDX = 1280, P1_QC = 1792, P1_KIDX = 2048, P1_WIDX = 2112;
constexpr int P0_K = 3072, P0_V = 4096, P0_QC = 5120;
constexpr size_t RB_PROJ0 = 0, RB_MIXCAT = (size_t)T * A_IN * 2;
constexpr size_t RB_ACT0 = 0;
constexpr size_t RB_PROJ1 = 0, RB_KVFULL = (size_t)T * B_INP * 2, RB_CKV = RB_KVFULL + (size_t)T * 2048 * 2,
                 RB_BITMASK = RB_CKV + (size_t)T * 256 * 2, RB_IDX = RB_BITMASK + (size_t)T * 64 * 4, RB_L1END = RB_IDX + (size_t)T * 256 * 2;
constexpr size_t RB_ML = RB_MIXCAT + (size_t)T * OUT_IN * 2;
constexpr size_t RB_XB = RB_ML + (size_t)3 * T * 16 * 2 * 4;
constexpr size_t RB_MIN = RB_XB + (size_t)T * D * 2;
static_assert(RB_L1END <= RB_MIXCAT, "layer-1 scratch overlaps mixcat");
}
using namespace cfg;

struct P {
    const float *x, *mem, *rel_bias, *mem_norm, *final_norm, *mixer_norm, *ffn_norm, *w_mem_kv, *w_out;
    const float *e_w_in, *e_w_gate, *e_w_up, *e_w_down;
    const float *o_w_in, *o_kv_norm, *o_w_uk, *o_w_uv, *o_w_router, *o_w_gate, *o_w_up, *o_w_down;
    float* out;
    unsigned* ctl;
    float* biasd;
    bf16_t *Wt_in0, *Wt_gu0, *Wt_down0, *Wt_out, *Wt_in1, *Wt_memkv, *Wt_ukv, *Wt_gu1, *Wt_down1;
    bf16_t *memn, *kvmem, *hmoe, *ybuf;
    int *tok_e, *tok_pos; float* tok_g; int* lists;
    float *ssq, *ssqc;
    char* rb;
    int nsplit, ph_lo, ph_hi, pad;
};

constexpr int CTL_CNT = 4096;
constexpr int CTL_WORDS = 8192;

DI int otid() { int t = threadIdx.x; asm volatile("" : "+v"(t)); return t; }
DI float bf2f(bf16_t b) { return __uint_as_float(((unsigned)b) << 16); }
DI bf16_t f2bf(float f) { unsigned u = __float_as_uint(f); u += 0x7FFFu + ((u >> 16) & 1u); return (bf16_t)(u >> 16); }
DI float wave_sum(float v) { for (int o = 32; o >= 1; o >>= 1) v += __shfl_xor(v, o); return v; }
DI float wave_max(float v) { for (int o = 32; o >= 1; o >>= 1) v = fmaxf(v, __shfl_xor(v, o)); return v; }
DI void wave_lds_sync() { asm volatile("s_waitcnt lgkmcnt(0)" ::: "memory"); __builtin_amdgcn_wave_barrier(); asm volatile("" ::: "memory"); }

DI int colmap(int mode, int n, int& which) {
    which = 0;
    if (mode == 0) return n;
    if (mode == 1) { const int j = n >> 8, r = n & 255; which = (r >= 128); return j * 128 + (r & 127); }
    if (n < 1792) return n;
    if (n < 2048) return 1864 + (n - 1792);
    if (n < 2112) return 1792 + (n - 2048);
    if (n < 2120) return 1856 + (n - 2112);
    return -1;
}
struct ConvJob { const float* s0; const float* s1; const float* gk; bf16_t* dst; int ld, K, Nd, mode, t0, nk; };
DI void conv_all(const ConvJob* jobs  , int njobs, int total, char* smem) {
    bf16_t* tl = (bf16_t*)smem;
    const int tid = otid();
    const int kl = tid >> 6, n4 = (tid & 63) * 4, nl = tid >> 3, kc = (tid & 7) * 8;
    float4 r[8]; float gs[8];
    int cj = 0, ck0 = 0, cn0 = 0;
    auto locate = [&](int g, int& j, int& k0, int& n0) { j = 0; while (j + 1 < njobs && g >= jobs[j + 1].t0) ++j; const int lt = g - jobs[j].t0, nk = jobs[j].nk; k0 = (lt % nk) * 64; n0 = (lt / nk) * 256; };
    auto issue = [&](int j, int k0, int n0) {
        int which; const int c = colmap(jobs[j].mode, n0 + n4, which); const float* sp = which ? jobs[j].s1 : jobs[j].s0; const int ld = jobs[j].ld; const float* gk = jobs[j].gk;
#pragma unroll
        for (int i = 0; i < 8; ++i) { r[i] = (c >= 0) ? *(const float4*)(sp + (size_t)(k0 + kl + 8 * i) * ld + c) : make_float4(0.f, 0.f, 0.f, 0.f); gs[i] = gk ? gk[k0 + kl + 8 * i] : 1.f; }
    };
    int g = blockIdx.x, it = 0;
    if (g < total) { locate(g, cj, ck0, cn0); issue(cj, ck0, cn0); }
    for (; g < total; g += gridDim.x, ++it) {
        bf16_t* t = tl + (it & 1) * (256 * 72);
        const int j = cj, k0 = ck0, n0 = cn0;
#pragma unroll
        for (int i = 0; i < 8; ++i) { const float sc = gs[i]; const int kk = kl + 8 * i;
            t[(n4 + 0) * 72 + kk] = f2bf(r[i].x * sc); t[(n4 + 1) * 72 + kk] = f2bf(r[i].y * sc); t[(n4 + 2) * 72 + kk] = f2bf(r[i].z * sc); t[(n4 + 3) * 72 + kk] = f2bf(r[i].w * sc); }
        const int gn = g + gridDim.x;
        if (gn < total) { locate(gn, cj, ck0, cn0); issue(cj, ck0, cn0); }
        __syncthreads();
        bf16_t* dp = jobs[j].dst + (size_t)(n0 + nl) * jobs[j].K + k0 + kc; const size_t rs = (size_t)64 * jobs[j].K;
#pragma unroll
        for (int i = 0; i < 4; ++i) *(uint4*)(dp + i * rs) = *(const uint4*)(t + (nl + 64 * i) * 72 + kc);
    }
    __syncthreads();
}

DI void rms_rows_bf16(const float* src, int rows, const float* g, bf16_t* dst) {
    const int lane = otid() & 63, gw = blockIdx.x * NWAVE + (otid() >> 6), nw = gridDim.x * NWAVE;
    for (int r = gw; r < rows; r += nw) {
        const float4* s = (const float4*)(src + (size_t)r * D);
        float4 v[4]; float ss = 0.f;
#pragma unroll
        for (int i = 0; i < 4; ++i) { v[i] = s[lane + 64 * i]; ss += v[i].x * v[i].x + v[i].y * v[i].y + v[i].z * v[i].z + v[i].w * v[i].w; }
        ss = wave_sum(ss);
        const float rstd = rsqrtf(ss * (1.0f / D) + 1e-6f);
#pragma unroll
        for (int i = 0; i < 4; ++i) {
            const float4 gg = ((const float4*)g)[lane + 64 * i];
            ushort4 o; o.x = f2bf(v[i].x * rstd * gg.x); o.y = f2bf(v[i].y * rstd * gg.y); o.z = f2bf(v[i].z * rstd * gg.z); o.w = f2bf(v[i].w * rstd * gg.w);
            ((ushort4*)(dst + (size_t)r * D))[lane + 64 * i] = o;
        }
    }
}

#define XB_TMO      128
#define XB_XCNT(j)  (256  + 64 * (j))
#define XB_XSUB(j)  (1280 + 64 * (j))
#define XB_XGEN(j)  (2304 + 64 * (j))
#define XB_TOP      3328
#define XB_TOPGEN   3392
#define XCD_BAR_WORDS 3456
#define XB_SPIN_CAP (1u << 20)
#define LAS __attribute__((address_space(3)))
__device__ __forceinline__ unsigned xb_ld(unsigned* p)              { return __hip_atomic_load(p, __ATOMIC_RELAXED, __HIP_MEMORY_SCOPE_AGENT); }
__device__ __forceinline__ unsigned xb_add(unsigned* p, unsigned v) { return __hip_atomic_fetch_add(p, v, __ATOMIC_RELAXED, __HIP_MEMORY_SCOPE_AGENT); }
__device__ __forceinline__ unsigned xb_xcc_id() { return (unsigned)__builtin_amdgcn_s_getreg((3 << 11) | 20) & 0xFu; }
#define XB_SPIN(cond, bar) do { unsigned _sp = 0; while (cond) { __builtin_amdgcn_s_sleep(1); \
    if ((++_sp & 255u) == 0u) { if (xb_ld(&(bar)[XB_TMO])) break; if (_sp > XB_SPIN_CAP) { atomicAdd(&(bar)[XB_TMO], 1u); break; } } } } while (0)
struct XcdBarrier { unsigned* bar; unsigned x; volatile LAS unsigned* st; };
__device__ __forceinline__ XcdBarrier xcd_barrier_post(unsigned* bar, volatile LAS unsigned* st) {
    XcdBarrier b; b.bar = bar; b.x = xb_xcc_id(); b.st = st;
    if (threadIdx.x == 0) (void)xb_add(&bar[XB_XCNT(b.x)], 1u);
    return b;
}
__device__ __forceinline__ void xcd_barrier_complete(unsigned* bar, unsigned x, unsigned& nloc, unsigned& nx) {
    const unsigned G = gridDim.x * gridDim.y * gridDim.z;
    unsigned sum, cnt, mine, sp = 0u;
    for (;;) {
        sum = 0u; cnt = 0u; mine = 0u;
#pragma unroll
        for (unsigned j = 0; j < 16; ++j) { const unsigned c = xb_ld(&bar[XB_XCNT(j)]); sum += c; cnt += (c > 0u) ? 1u : 0u; mine = (j == x) ? c : mine; }
        if (sum == G) break;
        __builtin_amdgcn_s_sleep(1);
        if ((++sp & 255u) == 0u) { if (xb_ld(&bar[XB_TMO])) break; if (sp > XB_SPIN_CAP) { atomicAdd(&bar[XB_TMO], 1u); break; } }
    }
    nloc = mine > 0u ? mine : 1u; nx = cnt > 0u ? cnt : 1u;
}
__device__ __forceinline__ void xcd_barrier(const XcdBarrier& b) {
    asm volatile("s_waitcnt vmcnt(0)" ::: "memory");
    __syncthreads();
    if (threadIdx.x == 0) {
        unsigned* bar = b.bar;
        __builtin_amdgcn_s_waitcnt(0);
        unsigned nloc = b.st[0], nx = b.st[1];
        if (nloc == 0u) { xcd_barrier_complete(bar, b.x, nloc, nx); b.st[0] = nloc; b.st[1] = nx; }
        const unsigned old = xb_add(&bar[XB_XSUB(b.x)], 1u);
        const unsigned gen = old / nloc;
        if (old + 1u == (gen + 1u) * nloc) {
            __builtin_amdgcn_fence(__ATOMIC_RELEASE, "agent");
            asm volatile("s_waitcnt vmcnt(0)" ::: "memory");
            const unsigned og = xb_add(&bar[XB_TOP], 1u);
            const unsigned tg = og / nx;
            if (og + 1u == (tg + 1u) * nx) xb_add(&bar[XB_TOPGEN], 1u);
            else XB_SPIN(xb_ld(&bar[XB_TOPGEN]) == tg, bar);
            __builtin_amdgcn_fence(__ATOMIC_ACQUIRE, "agent");
            xb_add(&bar[XB_XGEN(b.x)], 1u);
            asm volatile("s_waitcnt vmcnt(0)" ::: "memory");
        } else {
            XB_SPIN(xb_ld(&bar[XB_XGEN(b.x)]) == gen, bar);
            __builtin_amdgcn_fence(__ATOMIC_ACQUIRE, "agent");
            asm volatile("s_waitcnt vmcnt(0)" ::: "memory");
        }
    }
    __syncthreads();
}


namespace pg8 {
typedef short bf16x8 __attribute__((ext_vector_type(8)));
typedef float f32x4 __attribute__((ext_vector_type(4)));
typedef unsigned u32x4 __attribute__((ext_vector_type(4)));
constexpr int BM = 256, BK = 64, HALF = 128, HTB = HALF * BK * 2, STAGE_BYTES = 8 * HTB, NXCD = 8, WGM = 8;
DI int lds_byte(int r, int c) { const int st = (r >> 4) * 2 + (c >> 5), rr = r & 15, cc = c & 31, ob = rr * 64 + cc * 2; return st * 1024 + (ob ^ (((ob >> 9) & 1) << 5)); }
DI void stage_rc(int b, int& R, int& C) { const int st = b / 1024, sb = b % 1024, swz = sb ^ (((sb >> 9) & 1) << 5); R = (st >> 1) * 16 + swz / 64; C = (st & 1) * 32 + (swz % 64) / 2; }
DI int perm32(int rho) { const int n = rho >> 4, i = rho & 15; return 8 * (i >> 2) + 4 * n + (i & 3); }
struct Unit { int pm, pn, pb, e, mt, nvalid; };
struct Gemm { const bf16_t* A; const bf16_t* Bt; int K; int lda; };
struct StaticOrder {
    int nM, nN, nwg, G, c;
    DI void init(int M, int N, int G_, int c_) { nM = M / BM; nN = N / BM; nwg = nM * nN; G = G_; c = c_; }
    DI bool next(int i, Unit& u) const {
        const long L = (long)i * G + c; if (L >= nwg) return false;
        int wgid = (int)L; { const int q = nwg / NXCD, r = nwg % NXCD, xcd = wgid % NXCD, off = wgid / NXCD; wgid = (xcd < r ? xcd * (q + 1) : r * (q + 1) + (xcd - r) * q) + off; }
        const int nig = WGM * nN, gid = wgid / nig, fm = gid * WGM, gsz = (nM - fm) < WGM ? (nM - fm) : WGM;
        u.pm = fm + ((wgid % nig) % gsz); u.pn = (wgid % nig) / gsz; u.pb = u.pn; u.e = 0; u.mt = u.pm; u.nvalid = 256; return true;
    }
    DI const int* rowlist(const Unit&) const { return nullptr; }
};
struct GroupOrder {
    int nN, G, c, total, Tc; const int* lists;
    int tiles[8], toff[8], cnt[8];
    DI bool next(int i, Unit& u) const {
        const long L = (long)i * G + c; if (L >= total) return false;
        int l = (int)L, ee = 0, te = 1, toe = 0, ce = 0; bool found = false;
#pragma unroll
        for (int j = 0; j < 8; ++j) { const int n = tiles[j] * nN; if (!found) { if (l < n) { found = true; ee = j; te = tiles[j]; toe = toff[j]; ce = cnt[j]; } else l -= n; } }
        u.e = ee; u.mt = l % te; u.pn = l / te; u.pm = toe + u.mt; u.pb = ee * nN + u.pn; const int nv = ce - u.mt * 256; u.nvalid = nv < 256 ? nv : 256; return true;
    }
    DI const int* rowlist(const Unit& u) const { return lists + (size_t)u.e * Tc + u.mt * 256; }
};
DI unsigned cvt_pk_bf16(float lo, float hi) { unsigned r; asm volatile("v_cvt_pk_bf16_f32 %0, %1, %2" : "=v"(r) : "v"(lo), "v"(hi)); return r; }
struct EpiBf16 {
    static constexpr bool PERM = true;
    bf16_t* O; int ldc;
    DI void operator()(const f32x4 (&acc)[2][2][4][2], const Unit& u, int wr, int wc, int fr, int fq) const {
        const int row0 = u.pm * BM + wr * 64 + fr, col0 = u.pn * BM + wc * 32 + 8 * fq;
#pragma unroll
        for (int ai = 0; ai < 2; ++ai)
#pragma unroll
            for (int m = 0; m < 4; ++m) { bf16_t* rowp = O + (size_t)(row0 + ai * HALF + m * 16) * ldc + col0;
#pragma unroll
                for (int bj = 0; bj < 2; ++bj) { const f32x4 v0 = acc[ai][bj][m][0], v1 = acc[ai][bj][m][1];
                    u32x4 w; w.x = cvt_pk_bf16(v0[0], v0[1]); w.y = cvt_pk_bf16(v0[2], v0[3]); w.z = cvt_pk_bf16(v1[0], v1[1]); w.w = cvt_pk_bf16(v1[2], v1[3]);
                    *(u32x4*)(rowp + bj * HALF) = w; } }
    }
};
struct EpiResid {
    static constexpr bool PERM = false;
    const float* base; float* out;
    DI void operator()(const f32x4 (&acc)[2][2][4][2], const Unit& u, int wr, int wc, int fr, int fq) const {
        const int row0 = u.pm * BM + wr * 64 + fr, col0 = u.pn * BM + wc * 32 + 4 * fq;
#pragma unroll
        for (int ai = 0; ai < 2; ++ai)
#pragma unroll
            for (int m = 0; m < 4; ++m) { const size_t off = (size_t)(row0 + ai * HALF + m * 16) * 1024 + col0;
#pragma unroll
                for (int bj = 0; bj < 2; ++bj)
#pragma unroll
                    for (int n = 0; n < 2; ++n) { const f32x4 bs = *(const f32x4*)(base + off + bj * HALF + n * 16); *(f32x4*)(out + off + bj * HALF + n * 16) = bs + acc[ai][bj][m][n]; }
                asm volatile("" ::: "memory"); }
    }
};
struct EpiSwiglu {
    static constexpr bool PERM = true;
    bf16_t* O; int ldc;
    DI static float act(float g, float u) { return g * __builtin_amdgcn_rcpf(1.0f + __expf(-g)) * u; }
    DI void operator()(const f32x4 (&acc)[2][2][4][2], const Unit& u, int wr, int wc, int fr, int fq) const {
        const int row0 = u.pm * BM + wr * 64 + fr, col0 = u.pn * HALF + wc * 32 + 8 * fq;
#pragma unroll
        for (int ai = 0; ai < 2; ++ai)
#pragma unroll
            for (int m = 0; m < 4; ++m) { bf16_t* rowp = O + (size_t)(row0 + ai * HALF + m * 16) * ldc + col0;
                const f32x4 g0 = acc[ai][0][m][0], g1 = acc[ai][0][m][1], u0 = acc[ai][1][m][0], u1 = acc[ai][1][m][1];
                u32x4 w; w.x = cvt_pk_bf16(act(g0[0], u0[0]), act(g0[1], u0[1])); w.y = cvt_pk_bf16(act(g0[2], u0[2]), act(g0[3], u0[3]));
                w.z = cvt_pk_bf16(act(g1[0], u1[0]), act(g1[1], u1[1])); w.w = cvt_pk_bf16(act(g1[2], u1[2]), act(g1[3], u1[3]));
                *(u32x4*)rowp = w; }
    }
};

constexpr int LDS_PART = STAGE_BYTES;
DI float rstd_of(const float* ssq, int row) { const f32x4 v = *(const f32x4*)(ssq + (size_t)row * 4); return rsqrtf(((v[0] + v[1]) + (v[2] + v[3])) * (1.0f / 1024.0f) + 1e-6f); }
DI void row_reduce_store(LAS unsigned char* lds, const float (&s)[2][4], int wr, int wc, int fr, int fq, float* dst, int dstride) {
    LAS float* part = (LAS float*)(lds + LDS_PART);
#pragma unroll
    for (int ai = 0; ai < 2; ++ai)
#pragma unroll
        for (int m = 0; m < 4; ++m) { float v = s[ai][m]; v += __shfl_xor(v, 16); v += __shfl_xor(v, 32); if (fq == 0) part[(ai * HALF + wr * 64 + m * 16 + fr) * 4 + wc] = v; }
    asm volatile("s_waitcnt lgkmcnt(0)" ::: "memory"); __builtin_amdgcn_s_barrier(); asm volatile("" ::: "memory");
    const int t = threadIdx.x;
    if (t < 256) { const float a = part[t * 4 + 0], b = part[t * 4 + 1], c = part[t * 4 + 2], d = part[t * 4 + 3]; dst[(size_t)t * dstride] = (a + b) + (c + d); }
    asm volatile("s_waitcnt lgkmcnt(0)" ::: "memory"); __builtin_amdgcn_s_barrier(); asm volatile("" ::: "memory");
}
struct EpiResidNorm {
    static constexpr bool PERM = true;
    const float* base; float* out; bf16_t* xb; float* ssq; LAS unsigned char* lds;
    DI void operator()(const f32x4 (&acc)[2][2][4][2], const Unit& u, int wr, int wc, int fr, int fq) const {
        const int row0 = u.pm * BM + wr * 64 + fr, col0 = u.pn * BM + wc * 32 + 8 * fq;
        float sq[2][4];
#pragma unroll
        for (int ai = 0; ai < 2; ++ai)
#pragma unroll
            for (int m = 0; m < 4; ++m) { const size_t off = (size_t)(row0 + ai * HALF + m * 16) * 1024 + col0; float s = 0.f;
#pragma unroll
                for (int bj = 0; bj < 2; ++bj) {
                    const f32x4 v0 = *(const f32x4*)(base + off + bj * HALF) + acc[ai][bj][m][0], v1 = *(const f32x4*)(base + off + bj * HALF + 4) + acc[ai][bj][m][1];
                    *(f32x4*)(out + off + bj * HALF) = v0; *(f32x4*)(out + off + bj * HALF + 4) = v1;
                    u32x4 w; w.x = cvt_pk_bf16(v0[0], v0[1]); w.y = cvt_pk_bf16(v0[2], v0[3]); w.z = cvt_pk_bf16(v1[0], v1[1]); w.w = cvt_pk_bf16(v1[2], v1[3]);
                    *(u32x4*)(xb + off + bj * HALF) = w;
                    s += (v0[0] * v0[0] + v0[1] * v0[1]) + (v0[2] * v0[2] + v0[3] * v0[3]) + (v1[0] * v1[0] + v1[1] * v1[1]) + (v1[2] * v1[2] + v1[3] * v1[3]); }
                sq[ai][m] = s; asm volatile("" ::: "memory"); }
        row_reduce_store(lds, sq, wr, wc, fr, fq, ssq + (size_t)u.pm * BM * 4 + u.pn, 4);
    }
};
struct EpiSwigluN {
    static constexpr bool PERM = true;
    bf16_t* O; int ldc; const float* ssq;
    DI void operator()(const f32x4 (&acc)[2][2][4][2], const Unit& u, int wr, int wc, int fr, int fq) const {
        const int row0 = u.pm * BM + wr * 64 + fr, col0 = u.pn * HALF + wc * 32 + 8 * fq;
#pragma unroll
        for (int ai = 0; ai < 2; ++ai)
#pragma unroll
            for (int m = 0; m < 4; ++m) { const int row = row0 + ai * HALF + m * 16; const float rs = rstd_of(ssq, row); bf16_t* rowp = O + (size_t)row * ldc + col0;
                const f32x4 g0 = acc[ai][0][m][0] * rs, g1 = acc[ai][0][m][1] * rs, u0 = acc[ai][1][m][0] * rs, u1 = acc[ai][1][m][1] * rs;
                u32x4 w; w.x = cvt_pk_bf16(EpiSwiglu::act(g0[0], u0[0]), EpiSwiglu::act(g0[1], u0[1])); w.y = cvt_pk_bf16(EpiSwiglu::act(g0[2], u0[2]), EpiSwiglu::act(g0[3], u0[3]));
                w.z = cvt_pk_bf16(EpiSwiglu::act(g1[0], u1[0]), EpiSwiglu::act(g1[1], u1[1])); w.w = cvt_pk_bf16(EpiSwiglu::act(g1[2], u1[2]), EpiSwiglu::act(g1[3], u1[3]));
                *(u32x4*)rowp = w; }
    }
};
struct EpiBf16N {
    static constexpr bool PERM = true;
    bf16_t* O; int ldc; const float* ssq; float* ssqc; int ctile; LAS unsigned char* lds;
    DI void operator()(const f32x4 (&acc)[2][2][4][2], const Unit& u, int wr, int wc, int fr, int fq) const {
        const int row0 = u.pm * BM + wr * 64 + fr, col0 = u.pn * BM + wc * 32 + 8 * fq;
        float sq[2][4];
#pragma unroll
        for (int ai = 0; ai < 2; ++ai)
#pragma unroll
            for (int m = 0; m < 4; ++m) { const int row = row0 + ai * HALF + m * 16; const float rs = rstd_of(ssq, row); bf16_t* rowp = O + (size_t)row * ldc + col0; float s = 0.f;
#pragma unroll
                for (int bj = 0; bj < 2; ++bj) { const f32x4 v0 = acc[ai][bj][m][0] * rs, v1 = acc[ai][bj][m][1] * rs;
                    u32x4 w; w.x = cvt_pk_bf16(v0[0], v0[1]); w.y = cvt_pk_bf16(v0[2], v0[3]); w.z = cvt_pk_bf16(v1[0], v1[1]); w.w = cvt_pk_bf16(v1[2], v1[3]);
                    *(u32x4*)(rowp + bj * HALF) = w;
                    s += (v0[0] * v0[0] + v0[1] * v0[1]) + (v0[2] * v0[2] + v0[3] * v0[3]) + (v1[0] * v1[0] + v1[1] * v1[1]) + (v1[2] * v1[2] + v1[3] * v1[3]); }
                sq[ai][m] = s; }
        if (u.pn == ctile) row_reduce_store(lds, sq, wr, wc, fr, fq, ssqc + (size_t)u.pm * BM, 1);
    }
};
struct EpiBf16C {
    static constexpr bool PERM = true;
    bf16_t* O; int ldc; const float* ssqc;
    DI void operator()(const f32x4 (&acc)[2][2][4][2], const Unit& u, int wr, int wc, int fr, int fq) const {
        const int row0 = u.pm * BM + wr * 64 + fr, col0 = u.pn * BM + wc * 32 + 8 * fq;
#pragma unroll
        for (int ai = 0; ai < 2; ++ai)
#pragma unroll
            for (int m = 0; m < 4; ++m) { const int row = row0 + ai * HALF + m * 16; const float rs = rsqrtf(ssqc[row] * (1.0f / 256.0f) + 1e-6f); bf16_t* rowp = O + (size_t)row * ldc + col0;
#pragma unroll
                for (int bj = 0; bj < 2; ++bj) { const f32x4 v0 = acc[ai][bj][m][0] * rs, v1 = acc[ai][bj][m][1] * rs;
                    u32x4 w; w.x = cvt_pk_bf16(v0[0], v0[1]); w.y = cvt_pk_bf16(v0[2], v0[3]); w.z = cvt_pk_bf16(v1[0], v1[1]); w.w = cvt_pk_bf16(v1[2], v1[3]);
                    *(u32x4*)(rowp + bj * HALF) = w; } }
    }
};

template <class Epi, class Sched, bool ALIGN_EPI, bool GATHER>
DI void gemm_phase(LAS unsigned char* lds, const Gemm g, const Sched& S, const Epi& E) {
    int tid_ = threadIdx.x; asm volatile("" : "+v"(tid_));
    const int tid = tid_, wid = __builtin_amdgcn_readfirstlane(tid >> 6), lane = tid & 63, wr = wid >> 2, wc = wid & 3, fr = lane & 15, fq = lane >> 4;
    const int K = g.K, nt = K / BK;
    unsigned voffB[2];
#pragma unroll
    for (int i = 0; i < 2; ++i) { int R, C; stage_rc(tid * 16 + i * 8192, R, C); const int Rb = Epi::PERM ? ((R & ~31) + perm32(R & 31)) : R; voffB[i] = (unsigned)(Rb * K + C) * 2u; }
    const size_t kstep = (size_t)(BK * 2);
    const size_t hstep = (size_t)HALF * K * 2;
    const size_t tstep = 2 * hstep;
    const int lda = g.lda; const size_t hstepA = (size_t)HALF * lda * 2, tstepA = 2 * hstepA;
    const size_t hA = GATHER ? (size_t)0 : hstepA;
    const unsigned ldsw = (unsigned)wid * 1024u;
    const int aoff = lds_byte(wr * 64 + fr, fq * 8), boff = lds_byte(wc * 32 + fr, fq * 8);
#define PG8_SA(b, h) (((b) * 2 + (h)) * HTB)
#define PG8_SB(b, h) ((4 + (b) * 2 + (h)) * HTB)
#define PG8_STAGE(bufoff, gbase, voff) do { _Pragma("unroll") for (int _i = 0; _i < 2; ++_i) \
        __builtin_amdgcn_global_load_lds((const unsigned*)((const char*)(gbase) + (voff)[_i]), (LAS unsigned*)(lds + (bufoff) + ldsw + _i * 8192), 16, 0, 0); } while (0)
#define PG8_LDA(dst, b, h) do { _Pragma("unroll") for (int m = 0; m < 4; ++m) _Pragma("unroll") for (int k = 0; k < 2; ++k) dst[m][k] = *(const LAS bf16x8*)(lds + PG8_SA(b, h) + aoff + m * 2048 + k * 1024); } while (0)
#define PG8_LDB(dst, b, h) do { _Pragma("unroll") for (int n = 0; n < 2; ++n) _Pragma("unroll") for (int k = 0; k < 2; ++k) dst[n][k] = *(const LAS bf16x8*)(lds + PG8_SB(b, h) + boff + n * 2048 + k * 1024); } while (0)
#define PG8_MMA(ai, bj, At, Bt) do { __builtin_amdgcn_s_setprio(1); _Pragma("unroll") for (int m = 0; m < 4; ++m) _Pragma("unroll") for (int n = 0; n < 2; ++n) _Pragma("unroll") for (int k = 0; k < 2; ++k) \
        acc[ai][bj][m][n] = __builtin_amdgcn_mfma_f32_16x16x32_bf16(Bt[n][k], At[m][k], acc[ai][bj][m][n], 0, 0, 0); __builtin_amdgcn_s_setprio(0); } while (0)
#define PG8_WAIT_V(n) asm volatile("s_waitcnt vmcnt(" #n ")" ::: "memory")
#define PG8_WAIT_L(n) asm volatile("s_waitcnt lgkmcnt(" #n ")" ::: "memory")
#define PG8_BAR __builtin_amdgcn_s_barrier()
#define PG8_SCHED __builtin_amdgcn_sched_barrier(0)
#define PG8_AOFFS(u, o0, o1, base) do { \
        if constexpr (GATHER) { const int* _rl = S.rowlist(u); _Pragma("unroll") for (int _i = 0; _i < 2; ++_i) { int _R, _C; stage_rc(tid * 16 + _i * 8192, _R, _C); \
                const int _r0 = _R, _r1 = _R + HALF; const int _t0 = _rl[_r0 < (u).nvalid ? _r0 : 0], _t1 = _rl[_r1 < (u).nvalid ? _r1 : 0]; \
                o0[_i] = (unsigned)(_t0 * lda + _C) * 2u; o1[_i] = (unsigned)(_t1 * lda + _C) * 2u; } base = (const char*)g.A; } \
        else { _Pragma("unroll") for (int _i = 0; _i < 2; ++_i) { int _R, _C; stage_rc(tid * 16 + _i * 8192, _R, _C); o0[_i] = (unsigned)(_R * lda + _C) * 2u; o1[_i] = o0[_i]; } base = (const char*)g.A + (size_t)(u).pm * tstepA; } } while (0)
    Unit cur, nxt; int ui = 0;
    if (!S.next(0, cur)) return;
    f32x4 acc[2][2][4][2];
#pragma unroll
    for (int a = 0; a < 2; ++a)
#pragma unroll
        for (int b = 0; b < 2; ++b)
#pragma unroll
            for (int m = 0; m < 4; ++m)
#pragma unroll
                for (int n = 0; n < 2; ++n) acc[a][b][m][n] = (f32x4){0.f, 0.f, 0.f, 0.f};
    bf16x8 At[4][2], B0[2][2], B1[2][2];
    unsigned vA0[2], vA1[2], nA0[2], nA1[2];
    const char* cA; const char* cB = (const char*)g.Bt + (size_t)cur.pb * tstep;
    PG8_AOFFS(cur, vA0, vA1, cA);
    PG8_STAGE(PG8_SB(0, 0), cB, voffB); PG8_STAGE(PG8_SB(0, 1), cB + hstep, voffB); PG8_STAGE(PG8_SA(0, 0), cA, vA0); PG8_STAGE(PG8_SA(0, 1), cA + hA, vA1);
    if (wr == 1) PG8_BAR;
    PG8_WAIT_V(2); PG8_BAR;
    PG8_STAGE(PG8_SB(1, 0), cB + kstep, voffB); PG8_STAGE(PG8_SA(1, 0), cA + kstep, vA0); PG8_STAGE(PG8_SB(1, 1), cB + hstep + kstep, voffB);
    PG8_WAIT_V(6); PG8_BAR;
    for (;;) {
        const bool has_next = S.next(ui + 1, nxt);
        const char* nA = cA; const char* nB = has_next ? (const char*)g.Bt + (size_t)nxt.pb * tstep : cB;
#pragma unroll
        for (int i = 0; i < 2; ++i) { nA0[i] = vA0[i]; nA1[i] = vA1[i]; }
        if (has_next) PG8_AOFFS(nxt, nA0, nA1, nA);
#pragma unroll 1
        for (int t = 0; t < nt; t += 2) {
            const bool last = (t == nt - 2);
            const char* a1 = cA + (size_t)(t + 1) * kstep;
            const char* a2 = last ? nA : cA + (size_t)(t + 2) * kstep; const char* b2 = last ? nB : cB + (size_t)(t + 2) * kstep;
            const char* a3 = a2 + kstep; const char* b3 = b2 + kstep;
            unsigned s0[2], s1[2];
#pragma unroll
            for (int i = 0; i < 2; ++i) { s0[i] = (GATHER && last) ? nA0[i] : vA0[i]; s1[i] = (GATHER && last) ? nA1[i] : vA1[i]; }
            PG8_LDB(B0, 0, 0); PG8_LDB(B1, 0, 1); PG8_SCHED; PG8_LDA(At, 0, 0); PG8_STAGE(PG8_SA(1, 1), a1 + hA, vA1);
            PG8_WAIT_V(8); PG8_WAIT_L(0); PG8_BAR; PG8_MMA(0, 0, At, B0); PG8_MMA(0, 1, At, B1); PG8_BAR; PG8_SCHED;
            PG8_LDA(At, 0, 1); PG8_STAGE(PG8_SB(0, 0), b2, voffB); PG8_STAGE(PG8_SB(0, 1), b2 + hstep, voffB); PG8_STAGE(PG8_SA(0, 0), a2, s0);
            PG8_WAIT_V(8); PG8_WAIT_L(0); PG8_BAR; PG8_MMA(1, 0, At, B0); PG8_MMA(1, 1, At, B1); PG8_BAR; PG8_SCHED;
            PG8_LDB(B0, 1, 0); PG8_LDB(B1, 1, 1); PG8_SCHED; PG8_LDA(At, 1, 0); PG8_STAGE(PG8_SA(0, 1), a2 + hA, s1);
            PG8_WAIT_V(8); PG8_WAIT_L(0); PG8_BAR; PG8_MMA(0, 0, At, B0); PG8_MMA(0, 1, At, B1); PG8_BAR; PG8_SCHED;
            PG8_LDA(At, 1, 1); PG8_STAGE(PG8_SB(1, 0), b3, voffB); PG8_STAGE(PG8_SB(1, 1), b3 + hstep, voffB); PG8_STAGE(PG8_SA(1, 0), a3, s0);
            PG8_WAIT_V(8); PG8_WAIT_L(0); PG8_BAR; PG8_MMA(1, 0, At, B0); PG8_MMA(1, 1, At, B1); PG8_BAR; PG8_SCHED;
        }
        if constexpr (ALIGN_EPI) { if (wr == 0) PG8_BAR; }
        E(acc, cur, wr, wc, fr, fq);
        if (!has_next) break;
#pragma unroll
        for (int a = 0; a < 2; ++a)
#pragma unroll
            for (int b = 0; b < 2; ++b)
#pragma unroll
                for (int m = 0; m < 4; ++m)
#pragma unroll
                    for (int n = 0; n < 2; ++n) acc[a][b][m][n] = (f32x4){0.f, 0.f, 0.f, 0.f};
        cur = nxt; cA = nA; cB = nB; ++ui;
#pragma unroll
        for (int i = 0; i < 2; ++i) { vA0[i] = nA0[i]; vA1[i] = nA1[i]; }
        if constexpr (ALIGN_EPI) { if (wr == 1) PG8_BAR; }
    }
    PG8_WAIT_V(0);
    if constexpr (!ALIGN_EPI) { if (wr == 0) PG8_BAR; }
    PG8_BAR;
#undef PG8_SA
#undef PG8_SB
#undef PG8_STAGE
#undef PG8_LDA
#undef PG8_LDB
#undef PG8_MMA
#undef PG8_WAIT_V
#undef PG8_WAIT_L
#undef PG8_BAR
#undef PG8_SCHED
#undef PG8_AOFFS
}
}


namespace fa {
typedef short bf16x8 __attribute__((ext_vector_type(8)));
typedef short s16x4 __attribute__((ext_vector_type(4)));
typedef float f32x16 __attribute__((ext_vector_type(16)));
typedef unsigned u32x4 __attribute__((ext_vector_type(4)));
typedef float f32x2_t __attribute__((ext_vector_type(2))); typedef __bf16 bf16x2_t __attribute__((ext_vector_type(2)));
typedef short v4i16_t __attribute__((ext_vector_type(4)));
DI unsigned cvtpk(float lo, float hi) { f32x2_t v = {lo, hi}; bf16x2_t b = __builtin_convertvector(v, bf16x2_t); return __builtin_bit_cast(unsigned, b); }
DI s16x4 vtr(const LAS unsigned char* p) { return __builtin_bit_cast(s16x4, __builtin_amdgcn_ds_read_tr16_b64_v4i16((LAS v4i16_t*)p)); }
constexpr float LOG2E = 1.4426950408889634f, C2 = 0.125f * LOG2E, NEGB = -1.0e30f;
constexpr int VSTR = 192, VIMG = 32 * VSTR;

template <int MODE>
DI void flash_unit(const bf16_t* qrow, const bf16_t* kbase, const bf16_t* vbase, long krs, int st_begin, int st_end,
                   const LAS float* tbl, const unsigned* bmrow, LAS unsigned char* vimg, f32x16& o0, f32x16& o1, float& m_out, float& l_out) {
    const int lane = otid() & 63, r32 = lane & 31, hi = lane >> 5;
    bf16x8 qf[4];
#pragma unroll
    for (int ks = 0; ks < 4; ++ks) qf[ks] = *(const bf16x8*)(qrow + 16 * ks + 8 * hi);
    const int vrow0 = lane >> 3, vch = lane & 7;
    LAS unsigned char* vw = vimg + vrow0 * VSTR + vch * 16;
    const LAS unsigned char* vrd = vimg + (4 * hi + ((lane & 15) >> 2)) * VSTR + ((lane >> 4) & 1) * 32 + (lane & 3) * 8;
#pragma unroll
    for (int i = 0; i < 16; ++i) { o0[i] = 0.f; o1[i] = 0.f; }
    float m = NEGB, l = 0.f;
    bf16x8 kf[4]; u32x4 vr[4]; unsigned bw = 0u;
    {
        const bf16_t* kp = kbase + (long)(32 * st_begin + r32) * krs + 8 * hi;
#pragma unroll
        for (int ks = 0; ks < 4; ++ks) kf[ks] = *(const bf16x8*)(kp + 16 * ks);
#pragma unroll
        for (int j = 0; j < 4; ++j) vr[j] = *(const u32x4*)(vbase + (long)(32 * st_begin + vrow0 + 8 * j) * krs + vch * 8);
        if (MODE == 2) bw = bmrow[st_begin];
    }
    for (int st = st_begin; st < st_end; ++st) {
        bf16x8 kc[4]; u32x4 vc[4];
#pragma unroll
        for (int ks = 0; ks < 4; ++ks) kc[ks] = kf[ks];
#pragma unroll
        for (int j = 0; j < 4; ++j) vc[j] = vr[j];
        const unsigned bwc = bw;
        if (st + 1 < st_end) {
            const bf16_t* kp = kbase + (long)(32 * (st + 1) + r32) * krs + 8 * hi;
#pragma unroll
            for (int ks = 0; ks < 4; ++ks) kf[ks] = *(const bf16x8*)(kp + 16 * ks);
#pragma unroll
            for (int j = 0; j < 4; ++j) vr[j] = *(const u32x4*)(vbase + (long)(32 * (st + 1) + vrow0 + 8 * j) * krs + vch * 8);
            if (MODE == 2) bw = bmrow[st + 1];
        }
#pragma unroll
        for (int j = 0; j < 4; ++j) *(LAS u32x4*)(vw + j * 8 * VSTR) = vc[j];
        f32x16 sv;
#pragma unroll
        for (int i = 0; i < 16; ++i) sv[i] = 0.f;
#pragma unroll
        for (int ks = 0; ks < 4; ++ks) sv = __builtin_amdgcn_mfma_f32_32x32x16_bf16(kc[ks], qf[ks], sv, 0, 0, 0);
        float mx = NEGB;
        const unsigned bws = bwc >> (4 * hi);
#pragma unroll
        for (int i = 0; i < 16; ++i) {
            const int ci = (i & 3) + 8 * (i >> 2);
            float x;
            if (MODE == 0) x = sv[i] * C2;
            else x = __builtin_fmaf(sv[i], C2, tbl[32 * st + ci]);
            if (MODE == 2) x = ((bws >> ci) & 1u) ? x : NEGB;
            sv[i] = x; mx = fmaxf(mx, x);
        }
        mx = fmaxf(mx, __shfl_xor(mx, 32));
        const float mn = fmaxf(m, mx);
        if (__builtin_amdgcn_ballot_w64(mn > m) != 0ull) {
            const float al = __builtin_amdgcn_exp2f(m - mn);
            l *= al; m = mn;
#pragma unroll
            for (int i = 0; i < 16; ++i) { o0[i] *= al; o1[i] *= al; }
        }
        float ps = 0.f;
#pragma unroll
        for (int i = 0; i < 16; ++i) { const float pe = __builtin_amdgcn_exp2f(sv[i] - m); sv[i] = pe; ps += pe; }
        ps += __shfl_xor(ps, 32); l += ps;
        u32x4 w0, w1;
        w0.x = cvtpk(sv[0], sv[1]); w0.y = cvtpk(sv[2], sv[3]); w0.z = cvtpk(sv[4], sv[5]); w0.w = cvtpk(sv[6], sv[7]);
        w1.x = cvtpk(sv[8], sv[9]); w1.y = cvtpk(sv[10], sv[11]); w1.z = cvtpk(sv[12], sv[13]); w1.w = cvtpk(sv[14], sv[15]);
        const bf16x8 pb0 = __builtin_bit_cast(bf16x8, w0), pb1 = __builtin_bit_cast(bf16x8, w1);
#pragma unroll
        for (int dt = 0; dt < 2; ++dt) {
            const s16x4 a0 = vtr(vrd + dt * 64), a1 = vtr(vrd + 8 * VSTR + dt * 64), a2 = vtr(vrd + 16 * VSTR + dt * 64), a3 = vtr(vrd + 24 * VSTR + dt * 64);
            const bf16x8 v0 = (bf16x8){a0[0], a0[1], a0[2], a0[3], a1[0], a1[1], a1[2], a1[3]};
            const bf16x8 v1 = (bf16x8){a2[0], a2[1], a2[2], a2[3], a3[0], a3[1], a3[2], a3[3]};
            if (dt == 0) { o0 = __builtin_amdgcn_mfma_f32_32x32x16_bf16(v0, pb0, o0, 0, 0, 0); o0 = __builtin_amdgcn_mfma_f32_32x32x16_bf16(v1, pb1, o0, 0, 0, 0); }
            else         { o1 = __builtin_amdgcn_mfma_f32_32x32x16_bf16(v0, pb0, o1, 0, 0, 0); o1 = __builtin_amdgcn_mfma_f32_32x32x16_bf16(v1, pb1, o1, 0, 0, 0); }
        }
    }
    m_out = m; l_out = l;
}
DI void store_o(bf16_t* orow, const f32x16& o0, const f32x16& o1, float sc, int hi) {
#pragma unroll
    for (int g = 0; g < 4; ++g) {
        uint2 a, b2;
        a.x = cvtpk(o0[4 * g] * sc, o0[4 * g + 1] * sc); a.y = cvtpk(o0[4 * g + 2] * sc, o0[4 * g + 3] * sc);
        b2.x = cvtpk(o1[4 * g] * sc, o1[4 * g + 1] * sc); b2.y = cvtpk(o1[4 * g + 2] * sc, o1[4 * g + 3] * sc);
        *(uint2*)(orow + 8 * g + 4 * hi) = a; *(uint2*)(orow + 32 + 8 * g + 4 * hi) = b2;
    }
}
}

constexpr int NPH = 20;

DI void ph_prologue(const P& p, char* smem) {
    ConvJob* jobs = (ConvJob*)(smem + 2 * 256 * 72 * 2);
    if (otid() == 0) {
        int n = 0, t0 = 0;
        auto add = [&](const float* s0, const float* s1, const float* gk, bf16_t* dst, int ld, int K, int Nd, int mode) {
            ConvJob j; j.s0 = s0; j.s1 = s1; j.gk = gk; j.dst = dst; j.ld = ld; j.K = K; j.Nd = Nd; j.mode = mode; j.t0 = t0; j.nk = K / 64; jobs[n] = j; ++n; t0 += (K / 64) * (Nd / 256); };
        add(p.e_w_in, nullptr, nullptr, p.Wt_in0, A_IN, D, A_IN, 0);
        add(p.e_w_gate, p.e_w_up, p.ffn_norm, p.Wt_gu0, FF0, D, 2 * FF0, 1);
        add(p.e_w_down, nullptr, nullptr, p.Wt_down0, D, FF0, D, 0);
        add(p.w_out, nullptr, nullptr, p.Wt_out, D, OUT_IN, D, 0);
        add(p.w_out + (size_t)OUT_IN * D, nullptr, nullptr, p.Wt_out + (size_t)D * OUT_IN, D, OUT_IN, D, 0);
        add(p.o_w_in, nullptr, p.mixer_norm + D, p.Wt_in1, 2120, D, B_INP, 2);
        add(p.w_mem_kv, nullptr, nullptr, p.Wt_memkv, 512, D, 512, 0);
        add(p.w_mem_kv + (size_t)D * 512, nullptr, nullptr, p.Wt_memkv + (size_t)512 * D, 512, D, 512, 0);
        add(p.o_w_uk, nullptr, p.o_kv_norm, p.Wt_ukv, 1024, 256, 1024, 0);
        add(p.o_w_uv, nullptr, p.o_kv_norm, p.Wt_ukv + (size_t)1024 * 256, 1024, 256, 1024, 0);
        for (int e = 0; e < NE; ++e) {
            add(p.o_w_gate + (size_t)e * D * FF1, p.o_w_up + (size_t)e * D * FF1, nullptr, p.Wt_gu1 + (size_t)e * 2 * FF1 * D, FF1, D, 2 * FF1, 1);
            add(p.o_w_down + (size_t)e * FF1 * D, nullptr, nullptr, p.Wt_down1 + (size_t)e * D * FF1, D, FF1, D, 0);
        }
        jobs[n].t0 = t0;
        ((int*)(jobs + 32))[0] = n;
    }
    __syncthreads();
    { const int n = ((const int*)(jobs + 32))[0]; conv_all(jobs, n, jobs[n].t0, smem); }
    for (int i = blockIdx.x * NTHR + otid(); i < 2049 * 16; i += gridDim.x * NTHR) {
        const int dist = i >> 4, hh = i & 15; int bucket;
        if (dist < 16) bucket = dist;
        else { const float nf = (float)dist; int lg = 16 + (int)(logf(nf / 16.0f) / logf(128.0f) * 16.0f); bucket = lg < 31 ? lg : 31; }
        p.biasd[i] = p.rel_bias[bucket * 16 + hh];
    }
    rms_rows_bf16(p.mem, B * NMEM, p.mem_norm, p.memn);
    rms_rows_bf16(p.x, T, p.mixer_norm, (bf16_t*)(p.rb + RB_XB));
}


DI void ph_proj0(const P& p, LAS unsigned char* lds) {
    { pg8::Gemm g{p.memn, p.Wt_memkv, D, D}; pg8::StaticOrder S; S.init(B * NMEM, 1024, (int)gridDim.x, (int)blockIdx.x); pg8::EpiBf16 E{p.kvmem, 1024};
      pg8::gemm_phase<pg8::EpiBf16, pg8::StaticOrder, true, false>(lds, g, S, E); }
    { pg8::Gemm g{(const bf16_t*)(p.rb + RB_XB), p.Wt_in0, D, D}; pg8::StaticOrder S; S.init(T, A_IN, (int)gridDim.x, (int)blockIdx.x); pg8::EpiBf16 E{(bf16_t*)(p.rb + RB_PROJ0), A_IN};
      pg8::gemm_phase<pg8::EpiBf16, pg8::StaticOrder, true, false>(lds, g, S, E); }
}

DI void cross_flash(const P& p, int li, const bf16_t* proj, int ldp, int qoff, LAS unsigned char* lds) {
    const int tid = otid(), lane = tid & 63, wid = __builtin_amdgcn_readfirstlane(tid >> 6), r32 = lane & 31, hi = lane >> 5;
    LAS unsigned char* vimg = lds + wid * fa::VIMG;
    bf16_t* mixcat = (bf16_t*)(p.rb + RB_MIXCAT);
    const int gw = blockIdx.x * NWAVE + wid, nw = gridDim.x * NWAVE;
    for (int u = gw; u < B * 4 * 64; u += nw) {
        const int tt = u & 63, hc = (u >> 6) & 3, b = u >> 8;
        const size_t trow = (size_t)b * S + 32 * tt + r32;
        const bf16_t* kb = p.kvmem + (size_t)b * NMEM * 1024 + li * 512 + hc * 64;
        fa::f32x16 o0, o1; float m, l;
        fa::flash_unit<0>(proj + trow * ldp + qoff + hc * 64, kb, kb + 256, 1024, 0, 8, nullptr, nullptr, vimg, o0, o1, m, l);
        fa::store_o(mixcat + trow * OUT_IN + 1024 + hc * 64, o0, o1, 1.0f / l, hi);
    }
}

DI void ph_attn0(const P& p, LAS unsigned char* lds, bool dry = false) {
    const int tid = otid(), lane = tid & 63, wid = __builtin_amdgcn_readfirstlane(tid >> 6), r32 = lane & 31, hi = lane >> 5;
    LAS unsigned char* vimg = lds + wid * fa::VIMG;
    LAS float* rtb = (LAS float*)(lds + NWAVE * fa::VIMG);
    bf16_t* proj0 = (bf16_t*)(p.rb + RB_PROJ0);
    float* ml = (float*)(p.rb + RB_ML);
    for (int job = blockIdx.x; job < 256; job += gridDim.x) {
        const int b = job >> 5, head = (job >> 1) & 15, hf = job & 1;
        __syncthreads();
        for (int k = tid; k < 3 * 192; k += NTHR) { const int g = k / 192, j = 159 - (k - g * 192), d = (g == 0) ? 1 : (g == 1 ? 4 : 16);
            rtb[k] = (j >= 0 && j <= 128) ? p.biasd[(j * d) * 16 + head] * fa::LOG2E : fa::NEGB; }
        __syncthreads();
#pragma unroll 1
        for (int n = wid; n < 96; n += NWAVE) {
            const int g = n >> 5, qt = 2 * (n & 31) + hf, dsh = 2 * g, d = 1 << dsh;
            const int tpr = 64 >> dsh, r = qt / tpr, mt = qt - r * tpr, m0 = 32 * mt;
            const size_t tokq = (size_t)b * S + (size_t)(m0 + r32) * d + r;
            bf16_t* qrow = proj0 + tokq * A_IN + g * 1024 + head * 64;
            const bf16_t* kb = proj0 + ((long)b * S + r + (long)(m0 - 128) * d) * (long)A_IN + P0_K + head * 64;
            fa::f32x16 o0, o1; float m, l;
            fa::flash_unit<1>(qrow, kb, kb + (P0_V - P0_K), (long)d * A_IN, (mt >= 4) ? 0 : 4 - mt, 5, rtb + g * 192 + (31 - r32 + 4 * hi), nullptr, vimg, o0, o1, m, l);
            fa::store_o(dry ? (bf16_t*)(p.rb + RB_MIXCAT) + (tokq * OUT_IN + head * 64) : qrow, o0, o1, 1.0f / l, hi);
            if (hi == 0) *(float2*)(ml + (((size_t)g * T + tokq) * 16 + head) * 2) = make_float2(m, l);
        }
    }
    __syncthreads();
    cross_flash(p, 0, proj0, A_IN, P0_QC, lds);
}
DI void ph_comb0(const P& p) {
    const int tid = otid(), lane = tid & 63, gw = blockIdx.x * NWAVE + (tid >> 6), nw = gridDim.x * NWAVE;
    const bf16_t* proj0 = (const bf16_t*)(p.rb + RB_PROJ0); const float* ml = (const float*)(p.rb + RB_ML);
    bf16_t* mixcat = (bf16_t*)(p.rb + RB_MIXCAT);
    for (int t = gw; t < T; t += nw) {
        const int head = lane >> 2;
        float mg[3], lg[3];
#pragma unroll
        for (int g = 0; g < 3; ++g) { const float2 v = *(const float2*)(ml + (((size_t)g * T + t) * 16 + head) * 2); mg[g] = v.x; lg[g] = v.y; }
        const float M = fmaxf(mg[0], fmaxf(mg[1], mg[2]));
        float w[3], ws = 0.f;
#pragma unroll
        for (int g = 0; g < 3; ++g) { w[g] = __builtin_amdgcn_exp2f(mg[g] - M) * lg[g]; ws += w[g]; }
        const float inv = 1.0f / ws;
        float acc[16];
#pragma unroll
        for (int j = 0; j < 16; ++j) acc[j] = 0.f;
#pragma unroll
        for (int g = 0; g < 3; ++g) {
            const uint4 v0 = *(const uint4*)(proj0 + (size_t)t * A_IN + g * 1024 + lane * 16), v1 = *(const uint4*)(proj0 + (size_t)t * A_IN + g * 1024 + lane * 16 + 8);
            const unsigned wd[8] = {v0.x, v0.y, v0.z, v0.w, v1.x, v1.y, v1.z, v1.w}; const float wg = w[g] * inv;
#pragma unroll
            for (int j = 0; j < 8; ++j) { acc[2 * j] += wg * __uint_as_float(wd[j] << 16); acc[2 * j + 1] += wg * __uint_as_float(wd[j] & 0xffff0000u); }
        }
        uint4 o0, o1;
        o0.x = fa::cvtpk(acc[0], acc[1]); o0.y = fa::cvtpk(acc[2], acc[3]); o0.z = fa::cvtpk(acc[4], acc[5]); o0.w = fa::cvtpk(acc[6], acc[7]);
        o1.x = fa::cvtpk(acc[8], acc[9]); o1.y = fa::cvtpk(acc[10], acc[11]); o1.z = fa::cvtpk(acc[12], acc[13]); o1.w = fa::cvtpk(acc[14], acc[15]);
        *(uint4*)(mixcat + (size_t)t * OUT_IN + lane * 16) = o0; *(uint4*)(mixcat + (size_t)t * OUT_IN + lane * 16 + 8) = o1;
    }
}

DI void ph_outproj(const P& p, int li, LAS unsigned char* lds) {
    pg8::Gemm g{(const bf16_t*)(p.rb + RB_MIXCAT), p.Wt_out + (size_t)li * D * OUT_IN, OUT_IN, OUT_IN}; pg8::StaticOrder S; S.init(T, D, (int)gridDim.x, (int)blockIdx.x);
    if (li == 0) { pg8::EpiResidNorm E{p.x, p.out, (bf16_t*)(p.rb + RB_XB), p.ssq, lds}; pg8::gemm_phase<pg8::EpiResidNorm, pg8::StaticOrder, true, false>(lds, g, S, E); }
    else { pg8::EpiResid E{p.out, p.out}; pg8::gemm_phase<pg8::EpiResid, pg8::StaticOrder, true, false>(lds, g, S, E); }
}
DI void ph_gateup0(const P& p, LAS unsigned char* lds) {
    pg8::Gemm g{(const bf16_t*)(p.rb + RB_XB), p.Wt_gu0, D, D}; pg8::StaticOrder S; S.init(T, 2 * FF0, (int)gridDim.x, (int)blockIdx.x); pg8::EpiSwigluN E{(bf16_t*)(p.rb + RB_ACT0), FF0, p.ssq};
    pg8::gemm_phase<pg8::EpiSwigluN, pg8::StaticOrder, true, false>(lds, g, S, E);
}
DI void ph_down0(const P& p, LAS unsigned char* lds) {
    pg8::Gemm g{(const bf16_t*)(p.rb + RB_ACT0), p.Wt_down0, FF0, FF0}; pg8::StaticOrder S; S.init(T, D, (int)gridDim.x, (int)blockIdx.x);
    pg8::EpiResidNorm E{p.out, p.out, (bf16_t*)(p.rb + RB_XB), p.ssq, lds};
    pg8::gemm_phase<pg8::EpiResidNorm, pg8::StaticOrder, true, false>(lds, g, S, E);
}
DI void ph_proj1(const P& p, LAS unsigned char* lds) {
    pg8::Gemm g{(const bf16_t*)(p.rb + RB_XB), p.Wt_in1, D, D}; pg8::StaticOrder S; S.init(T, B_INP, (int)gridDim.x, (int)blockIdx.x);
    pg8::EpiBf16N E{(bf16_t*)(p.rb + RB_PROJ1), B_INP, p.ssq, p.ssqc, P1_CKV / 256, lds};
    pg8::gemm_phase<pg8::EpiBf16N, pg8::StaticOrder, true, false>(lds, g, S, E);
}

DI void ph_kvfull(const P& p, LAS unsigned char* lds) {
    pg8::Gemm g{(const bf16_t*)(p.rb + RB_PROJ1) + P1_CKV, p.Wt_ukv, 256, B_INP}; pg8::StaticOrder S; S.init(T, 2048, (int)gridDim.x, (int)blockIdx.x); pg8::EpiBf16C E{(bf16_t*)(p.rb + RB_KVFULL), 2048, p.ssqc};
    pg8::gemm_phase<pg8::EpiBf16C, pg8::StaticOrder, true, false>(lds, g, S, E);
}

DI void ph_topk(const P& p, char* smem) {
    constexpr int SCS = 2052;
    float* sc = (float*)smem;
    const int tid = otid(), lane = tid & 63, wid = __builtin_amdgcn_readfirstlane(tid >> 6);
    const bf16_t* proj1 = (const bf16_t*)(p.rb + RB_PROJ1);
    unsigned* bitmask = (unsigned*)(p.rb + RB_BITMASK);
    typedef short bf16x8 __attribute__((ext_vector_type(8))); typedef float f32x4 __attribute__((ext_vector_type(4)));
    for (int u0 = blockIdx.x, rnd = 0; u0 < T / 16; u0 += gridDim.x, ++rnd) {
        const int u = (rnd & 1) ? ((u0 & ~127) | (127 - (u0 & 127))) : u0;
        const int t0 = u * 16, b = t0 / S, tl0 = t0 % S, tmax = tl0 + 15;
        {
            const int qn = lane & 15, g4 = lane >> 4;
            const bf16_t* qrow = proj1 + (size_t)(t0 + qn) * B_INP;
            bf16x8 qf[8][2]; float wq[8];
#pragma unroll
            for (int hh = 0; hh < 8; ++hh) {
#pragma unroll
                for (int ks = 0; ks < 2; ++ks) qf[hh][ks] = *(const bf16x8*)(qrow + P1_QIDX + hh * 64 + 32 * ks + 8 * g4);
                wq[hh] = bf2f(qrow[P1_WIDX + hh]) * (0.35355339059327373f * 0.125f);
            }
            const int ntile = (tmax >> 4) + 1;
            const bf16_t* kbase = proj1 + ((size_t)b * S + qn) * B_INP + P1_KIDX + 8 * g4;
            bf16x8 kn0, kn1;
            if (wid < ntile) { kn0 = *(const bf16x8*)(kbase + (size_t)(16 * wid) * B_INP); kn1 = *(const bf16x8*)(kbase + (size_t)(16 * wid) * B_INP + 32); }
#pragma unroll 1
            for (int kt = wid; kt < ntile; kt += NWAVE) {
                const bf16x8 k0 = kn0, k1 = kn1;
                if (kt + NWAVE < ntile) { kn0 = *(const bf16x8*)(kbase + (size_t)(16 * (kt + NWAVE)) * B_INP); kn1 = *(const bf16x8*)(kbase + (size_t)(16 * (kt + NWAVE)) * B_INP + 32); }
                f32x4 acc = (f32x4){0.f, 0.f, 0.f, 0.f};
#pragma unroll
                for (int hh = 0; hh < 8; ++hh) {
                    f32x4 dd = (f32x4){0.f, 0.f, 0.f, 0.f};
                    dd = __builtin_amdgcn_mfma_f32_16x16x32_bf16(k0, qf[hh][0], dd, 0, 0, 0);
                    dd = __builtin_amdgcn_mfma_f32_16x16x32_bf16(k1, qf[hh][1], dd, 0, 0, 0);
#pragma unroll
                    for (int i = 0; i < 4; ++i) acc[i] += wq[hh] * fmaxf(dd[i], 0.f);
                }
#pragma unroll
                for (int i = 0; i < 4; ++i) acc[i] += 0.0f;
                *(f32x4*)(sc + qn * SCS + 16 * kt + 4 * g4) = acc;
            }
        }
        __syncthreads();
#pragma unroll 1
        for (int rr = 0; rr < 2; ++rr) {
            const int qi = wid * 2 + rr, t = t0 + qi, tl = tl0 + qi;
            unsigned uu[32];
#pragma unroll
            for (int i = 0; i < 32; ++i) {
                const int key = lane + 64 * i;
                unsigned v = 0u;
                if (key <= tl) { const unsigned bits = __float_as_uint(sc[qi * SCS + key]); v = (bits & 0x80000000u) ? ~bits : (bits | 0x80000000u); }
                uu[i] = v;
            }
            unsigned T_ = 0u; int need_eq = 0; bool all_causal = (tl + 1 <= 256);
            if (!all_causal) {
                unsigned v = 0u; bool exact = false;
#pragma unroll 1
                for (int bit = 31; bit >= 0; --bit) {
                    const unsigned cand = v | (1u << bit);
                    int cnt = 0;
#pragma unroll
                    for (int i = 0; i < 32; ++i) cnt += __builtin_popcountll(__ballot(uu[i] >= cand));
                    if (cnt >= 256) { v = cand; if (cnt == 256) { exact = true; break; } }
                }
                T_ = v;
                if (!exact) {
                    int ngt = 0;
#pragma unroll
                    for (int i = 0; i < 32; ++i) ngt += __builtin_popcountll(__ballot(uu[i] > T_));
                    need_eq = 256 - ngt;
                } else need_eq = -1;
            }
            unsigned myword = 0u; int taken = 0;
#pragma unroll
            for (int i = 0; i < 32; ++i) {
                const int key = lane + 64 * i;
                unsigned long long m;
                if (all_causal) m = __ballot(key <= tl);
                else if (need_eq < 0) m = __ballot(uu[i] >= T_);
                else {
                    const unsigned long long g = __ballot(uu[i] > T_); unsigned long long e = __ballot(uu[i] == T_);
                    const int c = __builtin_popcountll(e);
                    if (taken + c > need_eq) { unsigned long long sel = 0ull; int k2 = need_eq - taken; while (k2 > 0) { const unsigned long long low = e & (0ull - e); sel |= low; e ^= low; --k2; } e = sel; taken = need_eq; }
                    else taken += c;
                    m = g | e;
                }
                if (lane == 2 * i) myword = (unsigned)m;
                if (lane == 2 * i + 1) myword = (unsigned)(m >> 32);
            }
            bitmask[(size_t)t * 64 + lane] = myword;
        }
        __syncthreads();
    }
}

DI void ph_attn1(const P& p, LAS unsigned char* lds) {
    const int tid = otid(), lane = tid & 63, wid = __builtin_amdgcn_readfirstlane(tid >> 6), r32 = lane & 31, hi = lane >> 5;
    LAS unsigned char* vimg = lds + wid * fa::VIMG;
    LAS float* rtb = (LAS float*)(lds + NWAVE * fa::VIMG);
    const bf16_t* proj1 = (const bf16_t*)(p.rb + RB_PROJ1); const bf16_t* kvfull = (const bf16_t*)(p.rb + RB_KVFULL);
    const unsigned* bitmask = (const unsigned*)(p.rb + RB_BITMASK);
    bf16_t* mixcat = (bf16_t*)(p.rb + RB_MIXCAT);
    for (int job = blockIdx.x; job < 256; job += gridDim.x) {
        const int b = job >> 5, head = (job >> 1) & 15, hf = job & 1;
        __syncthreads();
        for (int k = tid; k < 2080; k += NTHR) { const int dist = 2047 - k; rtb[k] = (dist >= 0) ? p.biasd[dist * 16 + head] * fa::LOG2E : 0.f; }
        __syncthreads();
#pragma unroll 1
        for (int qi = 0; qi < 4; ++qi) {
            const int kk = (qi == 0) ? wid : (qi == 1) ? 15 - wid : (qi == 2) ? 16 + wid : 31 - wid;
            const int tt = hf + 2 * kk, tq = 32 * tt + r32;
            const size_t trow = (size_t)b * S + tq;
            const bf16_t* kb = kvfull + (size_t)b * S * 2048 + head * 64;
            fa::f32x16 o0, o1; float m, l;
            fa::flash_unit<2>(proj1 + trow * B_INP + P1_Q + head * 64, kb, kb + 1024, 2048, 0, tt + 1, rtb + (2047 - tq + 4 * hi), bitmask + trow * 64, vimg, o0, o1, m, l);
            fa::store_o(mixcat + trow * OUT_IN + head * 64, o0, o1, 1.0f / l, hi);
        }
    }
    __syncthreads();
    cross_flash(p, 1, proj1, B_INP, P1_QC, lds);
}

DI void ph_router(const P& p, char* smem) {
    int* lcnt = (int*)smem;
    int* lbase = lcnt + 8;
    int* le = lcnt + 16;
    int* lpos = le + 128;
    const int tid = otid(), lane = tid & 63, wid = __builtin_amdgcn_readfirstlane(tid >> 6);
    const int Tc = T / p.nsplit;
    const float* g = p.ffn_norm + D;
    float wr[4][4][8];
#pragma unroll
    for (int i = 0; i < 4; ++i)
#pragma unroll
        for (int j = 0; j < 4; ++j) { const int k = (lane + 64 * i) * 4 + j;
            const float4 w0 = *(const float4*)(p.o_w_router + (size_t)k * 8), w1 = *(const float4*)(p.o_w_router + (size_t)k * 8 + 4);
            wr[i][j][0] = w0.x; wr[i][j][1] = w0.y; wr[i][j][2] = w0.z; wr[i][j][3] = w0.w; wr[i][j][4] = w1.x; wr[i][j][5] = w1.y; wr[i][j][6] = w1.z; wr[i][j][7] = w1.w; }
    float4 gg[4];
#pragma unroll
    for (int i = 0; i < 4; ++i) gg[i] = ((const float4*)g)[lane + 64 * i];
    for (int grp = blockIdx.x; grp < T / 64; grp += gridDim.x) {
        if (tid < 8) lcnt[tid] = 0;
        __syncthreads();
#pragma unroll 1
        for (int jt = 0; jt < 8; ++jt) {
            const int tl = wid * 8 + jt, t = grp * 64 + tl;
            const float4* s = (const float4*)(p.out + (size_t)t * D);
            float4 v[4]; float ss = 0.f;
#pragma unroll
            for (int i = 0; i < 4; ++i) { v[i] = s[lane + 64 * i]; ss += v[i].x * v[i].x + v[i].y * v[i].y + v[i].z * v[i].z + v[i].w * v[i].w; }
            ss = wave_sum(ss);
            const float rstd = rsqrtf(ss * (1.0f / D) + 1e-6f);
            float lg[8];
#pragma unroll
            for (int e = 0; e < 8; ++e) lg[e] = 0.f;
#pragma unroll
            for (int i = 0; i < 4; ++i) {
                const float hv[4] = {v[i].x * rstd * gg[i].x, v[i].y * rstd * gg[i].y, v[i].z * rstd * gg[i].z, v[i].w * rstd * gg[i].w};
                ushort4 o; o.x = f2bf(hv[0]); o.y = f2bf(hv[1]); o.z = f2bf(hv[2]); o.w = f2bf(hv[3]);
                ((ushort4*)(p.hmoe + (size_t)t * D))[lane + 64 * i] = o;
#pragma unroll
                for (int j = 0; j < 4; ++j)
#pragma unroll
                    for (int e = 0; e < 8; ++e) lg[e] += hv[j] * wr[i][j][e];
            }
#pragma unroll
            for (int e = 0; e < 8; ++e) lg[e] = wave_sum(lg[e]);
            if (lane == 0) {
                int e1 = 0; float v1 = lg[0];
#pragma unroll
                for (int e = 1; e < 8; ++e) if (lg[e] > v1) { v1 = lg[e]; e1 = e; }
                int e2 = -1; float v2 = -3.0e38f;
#pragma unroll
                for (int e = 0; e < 8; ++e) if (e != e1 && lg[e] > v2) { v2 = lg[e]; e2 = e; }
                const float ex = __expf(v2 - v1); const float g1 = 1.0f / (1.0f + ex), g2 = ex / (1.0f + ex);
                le[tl * 2] = e1; le[tl * 2 + 1] = e2;
                lpos[tl * 2] = atomicAdd(lcnt + e1, 1); lpos[tl * 2 + 1] = atomicAdd(lcnt + e2, 1);
                p.tok_e[t * 2] = e1; p.tok_e[t * 2 + 1] = e2; p.tok_g[t * 2] = g1; p.tok_g[t * 2 + 1] = g2;
            }
        }
        __syncthreads();
        const int c = (grp * 64) / Tc;
        if (tid < 8) lbase[tid] = (int)atomicAdd(p.ctl + CTL_CNT + c * 8 + tid, (unsigned)lcnt[tid]);
        __syncthreads();
        if (tid < 128) { const int tl = tid >> 1, t = grp * 64 + tl, e = le[tid], pos = lbase[e] + lpos[tid];
            p.lists[((size_t)c * 8 + e) * Tc + pos] = t; p.tok_pos[t * 2 + (tid & 1)] = pos; }
        __syncthreads();
    }
}

DI void moe_offsets(const P& p, int c, int (&cnt)[8], int (&off)[8]) {
    int o = 0;
#pragma unroll
    for (int e = 0; e < 8; ++e) { cnt[e] = (int)__hip_atomic_load(p.ctl + CTL_CNT + c * 8 + e, __ATOMIC_RELAXED, __HIP_MEMORY_SCOPE_AGENT); off[e] = o; o += (cnt[e] + 255) & ~255; }
}
DI size_t moe_rowcap(const P& p) { return (size_t)(2 * (T / p.nsplit) + 2048); }

DI void moe_order(const P& p, int c, int nN, pg8::GroupOrder& S) {
    int cnt[8], off[8]; moe_offsets(p, c, cnt, off);
    S.nN = nN; S.G = (int)gridDim.x; S.c = (int)blockIdx.x; S.Tc = T / p.nsplit; S.lists = p.lists + (size_t)c * 8 * S.Tc;
    int tot = 0;
#pragma unroll
    for (int e = 0; e < 8; ++e) { S.cnt[e] = cnt[e]; S.tiles[e] = (cnt[e] + 255) >> 8; S.toff[e] = off[e] >> 8; tot += S.tiles[e] * nN; }
    S.total = tot;
}
DI void ph_moe_gateup(const P& p, int c, LAS unsigned char* lds) {
    pg8::GroupOrder S; moe_order(p, c, 2 * FF1 / 256, S);
    pg8::Gemm g{p.hmoe, p.Wt_gu1, D, D}; pg8::EpiSwiglu E{(bf16_t*)p.rb, FF1};
    pg8::gemm_phase<pg8::EpiSwiglu, pg8::GroupOrder, true, true>(lds, g, S, E);
}
DI void ph_moe_down(const P& p, int c, LAS unsigned char* lds) {
    pg8::GroupOrder S; moe_order(p, c, D / 256, S);
    pg8::Gemm g{(const bf16_t*)p.rb, p.Wt_down1, FF1, FF1}; pg8::EpiBf16 E{p.ybuf, D};
    pg8::gemm_phase<pg8::EpiBf16, pg8::GroupOrder, true, false>(lds, g, S, E);
}
DI void ph_moe_combine(const P& p, int c) {
    int cnt[8], off[8]; moe_offsets(p, c, cnt, off);
    const int Tc = T / p.nsplit;
    const bf16_t* ybuf = p.ybuf;
    const int lane = otid() & 63, gw = blockIdx.x * NWAVE + (otid() >> 6), nw = gridDim.x * NWAVE;
    for (int tt = gw; tt < Tc; tt += nw) {
        const int t = c * Tc + tt;
        const int e1 = p.tok_e[t * 2], e2 = p.tok_e[t * 2 + 1]; const float g1 = p.tok_g[t * 2], g2 = p.tok_g[t * 2 + 1];
        int o1 = 0, o2 = 0;
#pragma unroll
        for (int e = 0; e < 8; ++e) { if (e == e1) o1 = off[e]; if (e == e2) o2 = off[e]; }
        const bf16_t* y1 = ybuf + (size_t)(o1 + p.tok_pos[t * 2]) * D; const bf16_t* y2 = ybuf + (size_t)(o2 + p.tok_pos[t * 2 + 1]) * D;
        float4* xo = (float4*)(p.out + (size_t)t * D);
        float4 v[4]; float ss = 0.f;
#pragma unroll
        for (int i = 0; i < 4; ++i) {
            v[i] = xo[lane + 64 * i];
            const ushort4 a = ((const ushort4*)y1)[lane + 64 * i], bq = ((const ushort4*)y2)[lane + 64 * i];
            v[i].x += g1 * bf2f(a.x) + g2 * bf2f(bq.x); v[i].y += g1 * bf2f(a.y) + g2 * bf2f(bq.y); v[i].z += g1 * bf2f(a.z) + g2 * bf2f(bq.z); v[i].w += g1 * bf2f(a.w) + g2 * bf2f(bq.w);
            ss += v[i].x * v[i].x + v[i].y * v[i].y + v[i].z * v[i].z + v[i].w * v[i].w;
        }
        ss = wave_sum(ss);
        const float rstd = rsqrtf(ss * (1.0f / D) + 1e-6f);
#pragma unroll
        for (int i = 0; i < 4; ++i) {
            const float4 gg = ((const float4*)p.final_norm)[lane + 64 * i];
            xo[lane + 64 * i] = make_float4(v[i].x * rstd * gg.x, v[i].y * rstd * gg.y, v[i].z * rstd * gg.z, v[i].w * rstd * gg.w);
        }
    }
}

enum { PH_PRO = 0, PH_PROJ0, PH_ATTN0, PH_COMB0, PH_OUT0, PH_GU0, PH_DOWN0, PH_PROJ1, PH_KVTOPK, PH_ATTN1, PH_OUT1, PH_ROUTER, PH_MOE0 };

__global__ void __launch_bounds__(NTHR, 2) fwd(P p) {
    extern __shared__ __attribute__((aligned(16))) unsigned char lds[];
    char* smem = (char*)lds;
    LAS unsigned char* l3 = (LAS unsigned char*)lds;
    const int lo = p.ph_lo, hi = p.ph_hi;
    volatile LAS unsigned* stw = (volatile LAS unsigned*)((LAS unsigned char*)lds + (LDS_BYTES - 16));
    if (threadIdx.x < 4) stw[threadIdx.x] = 0u;
    __syncthreads();
    XcdBarrier bar; bar.bar = p.ctl; bar.x = 0; bar.st = stw;
    const bool fused = (hi - lo) > 1;
    if (fused) bar = xcd_barrier_post(p.ctl, stw);
#ifndef DUP_PH
#define DUP_PH -1
#endif
#ifndef DIAG_SEL
#define DIAG_SEL -1
#endif
    unsigned long long dg_acc = 0ull, dg_t0 = 0ull;
#define DG_NOW() __builtin_amdgcn_s_memrealtime()
#define IN(k) (lo <= (k) && (k) < hi)
#define SEAM(k) do { if (IN(k) && IN((k) + 1)) { if (DIAG_SEL == 100) dg_t0 = DG_NOW(); xcd_barrier(bar); if (DIAG_SEL == 100) dg_acc += DG_NOW() - dg_t0; } if (DIAG_SEL == (k)) dg_acc += DG_NOW() - dg_t0; } while (0)
#define RUN(k, call) do { if (DIAG_SEL == (k)) dg_t0 = DG_NOW(); if (IN(k)) { call; if (DUP_PH == (k)) { call; } } SEAM(k); } while (0)
    RUN(PH_PRO, ph_prologue(p, smem));
    RUN(PH_PROJ0, ph_proj0(p, l3));
    if (DIAG_SEL == PH_ATTN0) dg_t0 = DG_NOW();
    if (IN(PH_ATTN0)) { if (DUP_PH == PH_ATTN0) ph_attn0(p, l3, true); ph_attn0(p, l3); }
    SEAM(PH_ATTN0);
    RUN(PH_COMB0, ph_comb0(p));
    if (DIAG_SEL == PH_OUT0) dg_t0 = DG_NOW();
    if (IN(PH_OUT0)) ph_outproj(p, 0, l3);
    SEAM(PH_OUT0);
    RUN(PH_GU0, ph_gateup0(p, l3));
    if (DIAG_SEL == PH_DOWN0) dg_t0 = DG_NOW();
    if (IN(PH_DOWN0)) ph_down0(p, l3);
    SEAM(PH_DOWN0);
    RUN(PH_PROJ1, ph_proj1(p, l3));
    if (DIAG_SEL == PH_KVTOPK) dg_t0 = DG_NOW();
    if (IN(PH_KVTOPK)) { ph_kvfull(p, l3); ph_topk(p, smem); if (DUP_PH == PH_KVTOPK) { ph_topk(p, smem); } }
    SEAM(PH_KVTOPK);
    RUN(PH_ATTN1, ph_attn1(p, l3));
    if (DIAG_SEL == PH_OUT1) dg_t0 = DG_NOW();
    if (IN(PH_OUT1)) ph_outproj(p, 1, l3);
    SEAM(PH_OUT1);
    if (DIAG_SEL == PH_ROUTER) dg_t0 = DG_NOW();
    if (IN(PH_ROUTER)) ph_router(p, smem);
    SEAM(PH_ROUTER);
    for (int c = 0; c < p.nsplit; ++c) {
        const int base = PH_MOE0 + 3 * c;
        RUN(base, ph_moe_gateup(p, c, l3));
        RUN(base + 1, ph_moe_down(p, c, l3));
        if (DIAG_SEL == base + 2) dg_t0 = DG_NOW();
        if (IN(base + 2)) ph_moe_combine(p, c);
        if (c + 1 < p.nsplit) SEAM(base + 2); else if (DIAG_SEL == base + 2) dg_acc += DG_NOW() - dg_t0;
    }
    if (DIAG_SEL >= 0 && blockIdx.x == 0) { const unsigned long long te = DG_NOW() + dg_acc; while (DG_NOW() < te) __builtin_amdgcn_s_sleep(8); }
#undef IN
#undef SEAM
#undef RUN
}

static size_t align_up(size_t v, size_t a) { return (v + a - 1) / a * a; }

extern "C" void kernel_launch(void* const* d_in, const int* in_sizes, int n_in, void* d_out, int out_size, void* d_ws, size_t ws_size, hipStream_t stream) {
    (void)in_sizes; (void)n_in; (void)out_size;
    P p{};
    p.x = (const float*)d_in[0]; p.mem = (const float*)d_in[1]; p.rel_bias = (const float*)d_in[2]; p.mem_norm = (const float*)d_in[3];
    p.final_norm = (const float*)d_in[4]; p.mixer_norm = (const float*)d_in[5]; p.ffn_norm = (const float*)d_in[6]; p.w_mem_kv = (const float*)d_in[7];
    p.w_out = (const float*)d_in[8]; p.e_w_in = (const float*)d_in[9]; p.e_w_gate = (const float*)d_in[10]; p.e_w_up = (const float*)d_in[11];
    p.e_w_down = (const float*)d_in[12]; p.o_w_in = (const float*)d_in[13]; p.o_kv_norm = (const float*)d_in[14]; p.o_w_uk = (const float*)d_in[15];
    p.o_w_uv = (const float*)d_in[16]; p.o_w_router = (const float*)d_in[17]; p.o_w_gate = (const float*)d_in[18]; p.o_w_up = (const float*)d_in[19];
    p.o_w_down = (const float*)d_in[20];
    p.out = (float*)d_out;
    char* ws = (char*)d_ws; size_t o = 0;
    auto take = [&](size_t bytes) { char* r = ws + o; o = align_up(o + bytes, 256); return r; };
    p.ctl = (unsigned*)take(CTL_WORDS * 4);
    p.biasd = (float*)take(2049 * 16 * 4);
    p.Wt_in0 = (bf16_t*)take((size_t)A_IN * D * 2);
    p.Wt_gu0 = (bf16_t*)take((size_t)2 * FF0 * D * 2);
    p.Wt_down0 = (bf16_t*)take((size_t)D * FF0 * 2);
    p.Wt_in1 = (bf16_t*)take((size_t)B_INP * D * 2);
    p.Wt_memkv = (bf16_t*)take((size_t)2 * 512 * D * 2);
    p.Wt_ukv = (bf16_t*)take((size_t)2048 * 256 * 2);
    p.Wt_out = (bf16_t*)take((size_t)2 * D * OUT_IN * 2);
    p.hmoe = p.Wt_in0;
    if ((size_t)((char*)p.Wt_out - (char*)p.Wt_in0) < (size_t)T * D * 2) { fprintf(stderr, "kernel_launch: layout error (hmoe overlay)\n"); return; }
    p.Wt_gu1 = (bf16_t*)take((size_t)NE * 2 * FF1 * D * 2);
    p.Wt_down1 = (bf16_t*)take((size_t)NE * D * FF1 * 2);
    p.memn = (bf16_t*)take((size_t)B * NMEM * D * 2);
    p.kvmem = (bf16_t*)take((size_t)B * NMEM * 1024 * 2);
    p.tok_e = (int*)take((size_t)T * 2 * 4); p.tok_pos = (int*)take((size_t)T * 2 * 4); p.tok_g = (float*)take((size_t)T * 2 * 4);
    p.lists = (int*)take((size_t)NE * T * 4);
    p.ssq = (float*)take((size_t)T * 4 * 4); p.ssqc = (float*)take((size_t)T * 4);
    p.rb = take(0);
    const size_t fixed = o;
    int nsplit = 1;
    for (; nsplit <= 8; nsplit *= 2) {
        const size_t rowcap = (size_t)(2 * (T / nsplit) + 2048);
        size_t need = rowcap * FF1 * 2 + (nsplit == 1 ? 0 : rowcap * D * 2); if (need < RB_MIN) need = RB_MIN;
        if (fixed + need <= ws_size) break;
    }
    if (nsplit > 8) { fprintf(stderr, "kernel_launch: workspace too small (%zu)\n", ws_size); return; }
    p.nsplit = nsplit;
    p.ybuf = (nsplit == 1) ? p.Wt_gu1 : (bf16_t*)(p.rb + (size_t)(2 * (T / nsplit) + 2048) * FF1 * 2);
    static bool attr = false;
    if (!attr) { (void)hipFuncSetAttribute((const void*)fwd, hipFuncAttributeMaxDynamicSharedMemorySize, LDS_BYTES); attr = true; }
    (void)hipMemsetAsync(p.ctl, 0, CTL_WORDS * 4, stream);
    const int nph = PH_MOE0 + 3 * nsplit;
#if ONE_LAUNCH
    static int grid = 0;
    if (!grid) {
        int dev = 0, cus = 0, per_cu = 0;
        (void)hipGetDevice(&dev);
        (void)hipDeviceGetAttribute(&cus, hipDeviceAttributeMultiprocessorCount, dev);
        (void)hipOccupancyMaxActiveBlocksPerMultiprocessor(&per_cu, (const void*)fwd, NTHR, LDS_BYTES);
        (void)hipGetLastError();
        grid = cus * (per_cu < 1 ? per_cu : 1);
        if (grid <= 0) grid = -1;
    }
    if (grid < 0) return;
    p.ph_lo = 0; p.ph_hi = nph;
    hipLaunchKernelGGL(fwd, dim3(grid), dim3(NTHR), LDS_BYTES, stream, p);
#else
    for (int ph = 0; ph < nph; ++ph) {
        p.ph_lo = ph; p.ph_hi = ph + 1;
        hipLaunchKernelGGL(fwd, dim3(1024), dim3(NTHR), LDS_BYTES, stream, p);
    }
#endif
}
```
